# Optimizing an MI355X kernel written in HIP

```python
import math
import jax, jax.numpy as jnp
from jax import lax
import numpy as np

D_MODEL = 2048
BATCH = 1
SEQ = 8192
DEPTH = 1

SSM_WIDTH = D_MODEL // 2
SSM_GROUP = 16
SSM_GROUPS = SSM_WIDTH // SSM_GROUP
SSM_STATE = 64
ATTN_WIDTH = D_MODEL // 2
ATTN_HEADS = 8
ATTN_HEAD_DIM = ATTN_WIDTH // ATTN_HEADS // 2
ROPE_THETA = 10000.0
Q_BLOCK = 128
IN_WIDTH = SSM_WIDTH + 3 * ATTN_WIDTH + 2 * D_MODEL
N_GROUPS = 4
EXPERTS_PER_GROUP = 8
N_EXPERTS = N_GROUPS * EXPERTS_PER_GROUP
TOP_K = 2
D_FF_EXPERT = D_MODEL // 4
MOE_BLOCK = 128
NORM_EPS = 1e-6
SUBLN_EPS = 1e-5

kernel_name = "hybrid_s5_diffattn_hmoe_block"


def rms_norm(x, w, eps=NORM_EPS):
    xf = x.astype(jnp.float32)
    y = xf * lax.rsqrt(jnp.mean(xf * xf, axis=-1, keepdims=True) + eps)
    return (y * w.astype(jnp.float32)).astype(x.dtype)


def lambda_init_fn(layer_idx):
    return 0.8 - 0.6 * math.exp(-0.3 * layer_idx)


def s5_branch(u, lam_re, lam_im, log_dt, b_re, b_im, c_re, c_im, d_skip, glu_w, glu_b):
    bsz, seq = u.shape[0], u.shape[1]
    f32 = jnp.float32
    uf = u.astype(f32).reshape(bsz, seq, SSM_GROUPS, SSM_GROUP)
    lr = lam_re.astype(f32)
    li = lam_im.astype(f32)
    dt = jnp.exp(log_dt.astype(f32))[:, None]
    mag = jnp.exp(lr * dt)
    abar_re = mag * jnp.cos(li * dt)
    abar_im = mag * jnp.sin(li * dt)
    nr = abar_re - 1.0
    ni = abar_im
    den = lr * lr + li * li
    f_re = (nr * lr + ni * li) / den
    f_im = (ni * lr - nr * li) / den
    br = b_re.astype(f32)
    bi = b_im.astype(f32)
    bbar_re = f_re[..., None] * br - f_im[..., None] * bi
    bbar_im = f_re[..., None] * bi + f_im[..., None] * br
    bu_re = jnp.einsum('bsgm,gpm->bsgp', uf, bbar_re)
    bu_im = jnp.einsum('bsgm,gpm->bsgp', uf, bbar_im)
    a_re = jnp.broadcast_to(abar_re, bu_re.shape)
    a_im = jnp.broadcast_to(abar_im, bu_im.shape)

    def combine(e1, e2):
        a1r, a1i, b1r, b1i = e1
        a2r, a2i, b2r, b2i = e2
        return (a2r * a1r - a2i * a1i,
                a2r * a1i + a2i * a1r,
                a2r * b1r - a2i * b1i + b2r,
                a2r * b1i + a2i * b1r + b2i)

    _, _, x_re, x_im = lax.associative_scan(combine, (a_re, a_im, bu_re, bu_im), axis=1)
    y = (jnp.einsum('bsgp,gmp->bsgm', x_re, c_re.astype(f32))
         - jnp.einsum('bsgp,gmp->bsgm', x_im, c_im.astype(f32)))
    y = y.reshape(bsz, seq, SSM_WIDTH) + d_skip.astype(f32) * uf.reshape(bsz, seq, SSM_WIDTH)
    y = jax.nn.gelu(y)
    y = y * jax.nn.sigmoid(y @ glu_w.astype(f32) + glu_b.astype(f32))
    return y.astype(u.dtype)


def rope_cos_sin(positions, dim):
    inv_freq = 1.0 / (ROPE_THETA ** (jnp.arange(0, dim, 2, dtype=jnp.float32) / dim))
    ang = positions.astype(jnp.float32)[..., None] * inv_freq
    return jnp.cos(ang)[:, :, None, None, :], jnp.sin(ang)[:, :, None, None, :]


def apply_rope(t, cos, sin):
    half = t.shape[-1] // 2
    t1, t2 = t[..., :half], t[..., half:]
    return jnp.concatenate([t1 * cos - t2 * sin, t2 * cos + t1 * sin], axis=-1)


def diff_attention(q, k, v, positions, lam_q1, lam_k1, lam_q2, lam_k2, subln_w, lambda_init):
    bsz, seq = q.shape[0], q.shape[1]
    f32 = jnp.float32
    hd = ATTN_HEAD_DIM
    cos, sin = rope_cos_sin(positions, hd)
    qf = apply_rope(q.astype(f32).reshape(bsz, seq, ATTN_HEADS, 2, hd), cos, sin)
    kf = apply_rope(k.astype(f32).reshape(bsz, seq, ATTN_HEADS, 2, hd), cos, sin)
    vf = v.astype(f32).reshape(bsz, seq, ATTN_HEADS, 2 * hd)
    lam = (jnp.exp(jnp.sum(lam_q1.astype(f32) * lam_k1.astype(f32)))
           - jnp.exp(jnp.sum(lam_q2.astype(f32) * lam_k2.astype(f32))) + lambda_init)
    n_blk = seq // Q_BLOCK
    q_blocks = jnp.moveaxis(qf.reshape(bsz, n_blk, Q_BLOCK, ATTN_HEADS, 2, hd), 1, 0)
    key_pos = jnp.arange(seq)
    scale = hd ** -0.5

    def block(args):
        qb, bi = args
        s = jnp.einsum('bqhcd,bkhcd->bhcqk', qb, kf) * scale
        q_pos = bi * Q_BLOCK + jnp.arange(Q_BLOCK)
        mask = key_pos[None, :] <= q_pos[:, None]
        s = jnp.where(mask, s, -jnp.inf)
        p = jax.nn.softmax(s, axis=-1)
        a = p[:, :, 0] - lam * p[:, :, 1]
        return jnp.einsum('bhqk,bkhe->bqhe', a, vf)

    o = lax.map(block, (q_blocks, jnp.arange(n_blk)))
    o = jnp.moveaxis(o, 0, 1).reshape(bsz, seq, ATTN_HEADS, 2 * hd)
    o = o * lax.rsqrt(jnp.mean(o * o, axis=-1, keepdims=True) + SUBLN_EPS)
    o = o * subln_w.astype(f32) * (1.0 - lambda_init)
    return o.reshape(bsz, seq, ATTN_WIDTH).astype(q.dtype)


def hierarchical_moe(h, router_group_w, router_expert_w, w_gate, w_up, w_down):
    bsz, seq, dm = h.shape
    n_tok = bsz * seq
    f32 = jnp.float32
    hf = h.reshape(n_tok, dm)
    hf32 = hf.astype(f32)
    g_logits = hf32 @ router_group_w.astype(f32)
    g_prob = jax.nn.softmax(g_logits, axis=-1)
    g_val, g_idx = lax.top_k(g_prob, 1)
    e_logits = (hf32 @ router_expert_w.astype(f32)).reshape(n_tok, N_GROUPS, EXPERTS_PER_GROUP)
    e_sel = jnp.take_along_axis(e_logits, g_idx[:, :, None], axis=1)[:, 0]
    e_val, e_idx = lax.top_k(e_sel, TOP_K)
    gate = jax.nn.softmax(e_val, axis=-1) * g_val
    expert_id = g_idx * EXPERTS_PER_GROUP + e_idx

    n_slots = n_tok * TOP_K
    e_flat = expert_id.reshape(n_slots)
    tok_flat = jnp.repeat(jnp.arange(n_tok, dtype=jnp.int32), TOP_K)
    w_flat = gate.reshape(n_slots)
    order = jnp.argsort(e_flat)
    sorted_e = e_flat[order]
    counts = jnp.bincount(e_flat, length=N_EXPERTS)
    starts = jnp.cumsum(counts) - counts
    padded = ((counts + MOE_BLOCK - 1) // MOE_BLOCK) * MOE_BLOCK
    padded_ends = jnp.cumsum(padded)
    padded_starts = padded_ends - padded
    dest = padded_starts[sorted_e] + (jnp.arange(n_slots) - starts[sorted_e])
    buf_len = n_slots + N_EXPERTS * MOE_BLOCK
    n_blocks = buf_len // MOE_BLOCK
    buf_tok = jnp.zeros((buf_len,), jnp.int32).at[dest].set(tok_flat[order])
    buf_w = jnp.zeros((buf_len,), f32).at[dest].set(w_flat[order])
    block_start = jnp.arange(n_blocks) * MOE_BLOCK
    block_e = jnp.clip(jnp.searchsorted(padded_ends, block_start, side='right'), 0, N_EXPERTS - 1)

    def expert_block(args):
        tok, e = args
        xb = hf[tok]
        a = jax.nn.silu(xb @ w_gate[e]) * (xb @ w_up[e])
        return a @ w_down[e]

    ys = lax.map(expert_block, (buf_tok.reshape(n_blocks, MOE_BLOCK), block_e))
    ys = ys.reshape(buf_len, dm)
    out = jnp.zeros((n_tok, dm), hf.dtype).at[buf_tok].add(ys * buf_w[:, None].astype(ys.dtype))
    return out.reshape(bsz, seq, dm)


def setup_inputs(seed: int = 0) -> dict:
    key = jax.random.key(seed)
    ks = jax.random.split(key, 32)
    f32 = jnp.float32
    L, D, G, P, M = DEPTH, D_MODEL, SSM_GROUPS, SSM_STATE, SSM_GROUP
    nrm = lambda k, shape, s: jax.random.normal(k, shape, f32) * s
    x = jax.random.normal(ks[0], (BATCH, SEQ, D), f32)
    positions = jnp.broadcast_to(jnp.arange(SEQ, dtype=jnp.int32), (BATCH, SEQ))
    n_idx = jnp.arange(P, dtype=f32)[None, None, :]
    return {
        "x": x,
        "positions": positions,
        "norm1_w": 1.0 + nrm(ks[1], (L, D), 0.02),
        "w_in": nrm(ks[2], (L, D, IN_WIDTH), D ** -0.5),
        "ssm_lambda_re": -0.5 + nrm(ks[3], (L, G, P), 0.01),
        "ssm_lambda_im": jnp.pi * n_idx + nrm(ks[4], (L, G, P), 0.01),
        "ssm_log_dt": jax.random.uniform(ks[5], (L, G), f32, math.log(1e-3), math.log(1e-1)),
        "ssm_b_re": nrm(ks[6], (L, G, P, M), (2 * M) ** -0.5),
        "ssm_b_im": nrm(ks[7], (L, G, P, M), (2 * M) ** -0.5),
        "ssm_c_re": nrm(ks[8], (L, G, M, P), P ** -0.5),
        "ssm_c_im": nrm(ks[9], (L, G, M, P), P ** -0.5),
        "ssm_d": nrm(ks[10], (L, SSM_WIDTH), 0.5),
        "ssm_glu_w": nrm(ks[11], (L, SSM_WIDTH, SSM_WIDTH), SSM_WIDTH ** -0.5),
        "ssm_glu_b": nrm(ks[12], (L, SSM_WIDTH), 0.01),
        "attn_lambda_q1": nrm(ks[13], (L, ATTN_HEAD_DIM), 0.1),
        "attn_lambda_k1": nrm(ks[14], (L, ATTN_HEAD_DIM), 0.1),
        "attn_lambda_q2": nrm(ks[15], (L, ATTN_HEAD_DIM), 0.1),
        "attn_lambda_k2": nrm(ks[16], (L, ATTN_HEAD_DIM), 0.1),
        "attn_subln_w": 1.0 + nrm(ks[17], (L, 2 * ATTN_HEAD_DIM), 0.02),
        "w_proj_ssm": nrm(ks[18], (L, SSM_WIDTH, D), SSM_WIDTH ** -0.5),
        "w_proj_attn": nrm(ks[19], (L, ATTN_WIDTH, D), ATTN_WIDTH ** -0.5),
        "w_out": nrm(ks[20], (L, D, D), D ** -0.5),
        "norm2_w": 1.0 + nrm(ks[21], (L, D), 0.02),
        "router_group_w": nrm(ks[22], (L, D, N_GROUPS), D ** -0.5),
        "router_expert_w": nrm(ks[23], (L, D, N_EXPERTS), D ** -0.5),
        "expert_w_gate": nrm(ks[24], (L, N_EXPERTS, D, D_FF_EXPERT), D ** -0.5),
        "expert_w_up": nrm(ks[25], (L, N_EXPERTS, D, D_FF_EXPERT), D ** -0.5),
        "expert_w_down": nrm(ks[26], (L, N_EXPERTS, D_FF_EXPERT, D), D_FF_EXPERT ** -0.5),
        "final_norm_w": 1.0 + nrm(ks[27], (D,), 0.02),
    }


def reference(x, positions, norm1_w, w_in, ssm_lambda_re, ssm_lambda_im, ssm_log_dt,
              ssm_b_re, ssm_b_im, ssm_c_re, ssm_c_im, ssm_d, ssm_glu_w, ssm_glu_b,
              attn_lambda_q1, attn_lambda_k1, attn_lambda_q2, attn_lambda_k2, attn_subln_w,
              w_proj_ssm, w_proj_attn, w_out, norm2_w, router_group_w, router_expert_w,
              expert_w_gate, expert_w_up, expert_w_down, final_norm_w):
    o_q = SSM_WIDTH
    o_k = o_q + ATTN_WIDTH
    o_v = o_k + ATTN_WIDTH
    o_gs = o_v + ATTN_WIDTH
    o_ga = o_gs + D_MODEL
    for l in range(DEPTH):
        h = rms_norm(x, norm1_w[l])
        z = h @ w_in[l]
        u = z[..., :o_q]
        q = z[..., o_q:o_k]
        k = z[..., o_k:o_v]
        v = z[..., o_v:o_gs]
        g_ssm = jax.nn.sigmoid(z[..., o_gs:o_ga])
        g_attn = jax.nn.sigmoid(z[..., o_ga:])
        y_ssm = s5_branch(u, ssm_lambda_re[l], ssm_lambda_im[l], ssm_log_dt[l],
                          ssm_b_re[l], ssm_b_im[l], ssm_c_re[l], ssm_c_im[l],
                          ssm_d[l], ssm_glu_w[l], ssm_glu_b[l])
        y_attn = diff_attention(q, k, v, positions, attn_lambda_q1[l], attn_lambda_k1[l],
                                attn_lambda_q2[l], attn_lambda_k2[l], attn_subln_w[l],
                                lambda_init_fn(l))
        merged = g_ssm * (y_ssm @ w_proj_ssm[l]) + g_attn * (y_attn @ w_proj_attn[l])
        x = x + merged @ w_out[l]
        h2 = rms_norm(x, norm2_w[l])
        x = x + hierarchical_moe(h2, router_group_w[l], router_expert_w[l],
                                 expert_w_gate[l], expert_w_up[l], expert_w_down[l])
    return rms_norm(x, final_norm_w)
```

```cpp
#include <hip/hip_runtime.h>
#include <cstdio>
#include <cstdint>

namespace {
constexpr int S = 8192, D = 2048, INW = 8192;
constexpr int SSMW = 1024, NG = 64, GM = 16, NP = 64;
constexpr int NH = 8, HD = 64, AW = 1024;
constexpr int O_Q = 1024, O_K = 2048, O_V = 3072, O_GS = 4096, O_GA = 6144;
constexpr int NE = 32, EPG = 8, NGRP = 4, DFF = 512;
constexpr float NORM_EPS = 1e-6f, SUBLN_EPS = 1e-5f, LAMBDA_INIT = 0.2f;

__device__ __forceinline__ float wave_sum(float v) {
#pragma unroll
    for (int o = 1; o < 64; o <<= 1) v += __shfl_xor(v, o);
    return v;
}
__device__ __forceinline__ float wave_max(float v) {
#pragma unroll
    for (int o = 1; o < 64; o <<= 1) v = fmaxf(v, __shfl_xor(v, o));
    return v;
}
__device__ __forceinline__ float sigmoidf_(float x) { return 1.f / (1.f + expf(-x)); }
__device__ __forceinline__ float gelu_tanh(float x) {
    const float k = 0.7978845608028654f;
    return 0.5f * x * (1.f + tanhf(k * (x + 0.044715f * x * x * x)));
}

__global__ void k_rmsnorm(const float* __restrict__ x, const float* __restrict__ w, float* __restrict__ out) {
    const int row = blockIdx.x, lane = threadIdx.x;
    const float* xr = x + (size_t)row * D;
    float v[32]; float s = 0.f;
#pragma unroll
    for (int j = 0; j < 32; ++j) { v[j] = xr[lane + 64 * j]; s += v[j] * v[j]; }
    s = wave_sum(s);
    const float r = rsqrtf(s / D + NORM_EPS);
#pragma unroll
    for (int j = 0; j < 32; ++j) out[(size_t)row * D + lane + 64 * j] = v[j] * r * w[lane + 64 * j];
}

__global__ void __launch_bounds__(256) k_gemm(const float* __restrict__ A, int lda, const float* __restrict__ B, int ldb,
                                              float* __restrict__ C, int ldc, int K) {
    __shared__ float As[16][64 + 4];
    __shared__ float Bs[16][64 + 4];
    const int tid = threadIdx.x, tx = tid & 15, ty = tid >> 4;
    const int m0 = blockIdx.y * 64, n0 = blockIdx.x * 64;
    float acc[4][4] = {};
    for (int k0 = 0; k0 < K; k0 += 16) {
#pragma unroll
        for (int i = 0; i < 4; ++i) { const int e = tid + 256 * i; const int r = e >> 4, c = e & 15; As[c][r] = A[(size_t)(m0 + r) * lda + k0 + c]; }
#pragma unroll
        for (int i = 0; i < 4; ++i) { const int e = tid + 256 * i; const int r = e >> 6, c = e & 63; Bs[r][c] = B[(size_t)(k0 + r) * ldb + n0 + c]; }
        __syncthreads();
#pragma unroll
        for (int kk = 0; kk < 16; ++kk) {
            float a[4], b[4];
#pragma unroll
            for (int i = 0; i < 4; ++i) { a[i] = As[kk][ty * 4 + i]; b[i] = Bs[kk][tx * 4 + i]; }
#pragma unroll
            for (int i = 0; i < 4; ++i)
#pragma unroll
                for (int j = 0; j < 4; ++j) acc[i][j] = fmaf(a[i], b[j], acc[i][j]);
        }
        __syncthreads();
    }
#pragma unroll
    for (int i = 0; i < 4; ++i)
#pragma unroll
        for (int j = 0; j < 4; ++j) C[(size_t)(m0 + ty * 4 + i) * ldc + n0 + tx * 4 + j] = acc[i][j];
}

__global__ void k_rope(float* __restrict__ z, const int* __restrict__ pos) {
    const size_t gid = (size_t)blockIdx.x * blockDim.x + threadIdx.x;
    const int i = gid & 31; const int blk = (gid >> 5) & 31; const int row = (int)(gid >> 10);
    if (row >= S) return;
    const float inv_freq = 1.0f / powf(10000.0f, (float)(2 * i) / 64.0f);
    const float ang = (float)pos[row] * inv_freq;
    const double a = (double)ang;
    const float c = (float)cos(a), s = (float)sin(a);
    float* p = z + (size_t)row * INW + O_Q + blk * 64;
    const float t1 = p[i], t2 = p[i + 32];
    p[i] = t1 * c - t2 * s; p[i + 32] = t2 * c + t1 * s;
}

__global__ void __launch_bounds__(64) k_ssm(const float* __restrict__ z, const float* __restrict__ lam_re, const float* __restrict__ lam_im,
                                            const float* __restrict__ log_dt, const float* __restrict__ b_re, const float* __restrict__ b_im,
                                            const float* __restrict__ c_re, const float* __restrict__ c_im, const float* __restrict__ dsk,
                                            float* __restrict__ ypre) {
    const int g = blockIdx.x, p = threadIdx.x;
    const float lr = lam_re[g * NP + p], li = lam_im[g * NP + p];
    const float dt = expf(log_dt[g]);
    const float mag = expf(lr * dt);
    const float ar = mag * cosf(li * dt), ai = mag * sinf(li * dt);
    const float nr = ar - 1.f, ni = ai, den = lr * lr + li * li;
    const float fr = (nr * lr + ni * li) / den, fi = (ni * lr - nr * li) / den;
    float bbr[GM], bbi[GM], cr[GM], ci[GM];
#pragma unroll
    for (int m = 0; m < GM; ++m) {
        const float br = b_re[(g * NP + p) * GM + m], bi = b_im[(g * NP + p) * GM + m];
        bbr[m] = fr * br - fi * bi; bbi[m] = fr * bi + fi * br;
        cr[m] = c_re[(g * GM + m) * NP + p]; ci[m] = c_im[(g * GM + m) * NP + p];
    }
    const float dm = (p < GM) ? dsk[g * GM + p] : 0.f;
    float xr = 0.f, xi = 0.f;
    for (int t = 0; t < S; ++t) {
        const float* ut = z + (size_t)t * INW + g * GM;
        float u[GM];
#pragma unroll
        for (int m = 0; m < GM; ++m) u[m] = ut[m];
        float bur = 0.f, bui = 0.f;
#pragma unroll
        for (int m = 0; m < GM; ++m) { bur = fmaf(bbr[m], u[m], bur); bui = fmaf(bbi[m], u[m], bui); }
        const float nxr = ar * xr - ai * xi + bur;
        const float nxi = ar * xi + ai * xr + bui;
        xr = nxr; xi = nxi;
        float mine = 0.f, myu = 0.f;
#pragma unroll
        for (int m = 0; m < GM; ++m) {
            const float v = wave_sum(cr[m] * xr - ci[m] * xi);
            if (p == m) { mine = v; myu = u[m]; }
        }
        if (p < GM) ypre[(size_t)t * SSMW + g * GM + p] = gelu_tanh(mine + dm * myu);
    }
}

__global__ void k_glu(const float* __restrict__ ypre, const float* __restrict__ lin, const float* __restrict__ b, float* __restrict__ yssm) {
    const size_t i = (size_t)blockIdx.x * blockDim.x + threadIdx.x;
    if (i >= (size_t)S * SSMW) return;
    const int c = (int)(i % SSMW);
    yssm[i] = ypre[i] * sigmoidf_(lin[i] + b[c]);
}

__global__ void __launch_bounds__(64) k_attn(const float* __restrict__ z, const float* __restrict__ lq1, const float* __restrict__ lk1,
                                             const float* __restrict__ lq2, const float* __restrict__ lk2, const float* __restrict__ subw,
                                             float* __restrict__ yattn) {
    extern __shared__ float sm[];
    const int h = blockIdx.x & 7, row = blockIdx.x >> 3, lane = threadIdx.x;
    float s1 = 0.f, s2 = 0.f;
    s1 = wave_sum(lq1[lane] * lk1[lane]); s2 = wave_sum(lq2[lane] * lk2[lane]);
    const float lam = expf(s1) - expf(s2) + LAMBDA_INIT;
    const int nk = row + 1;
    float linv[2];
    for (int c = 0; c < 2; ++c) {
        float q[HD];
        const float* qp = z + (size_t)row * INW + O_Q + h * 128 + c * 64;
#pragma unroll
        for (int d = 0; d < HD; ++d) q[d] = qp[d];
        float* sc = sm + c * S;
        float mx = -INFINITY;
        for (int j = lane; j < nk; j += 64) {
            const float* kp = z + (size_t)j * INW + O_K + h * 128 + c * 64;
            float a = 0.f;
#pragma unroll
            for (int d = 0; d < HD; ++d) a = fmaf(q[d], kp[d], a);
            a *= 0.125f; sc[j] = a; mx = fmaxf(mx, a);
        }
        mx = wave_max(mx);
        float l = 0.f;
        for (int j = lane; j < nk; j += 64) { const float e = expf(sc[j] - mx); sc[j] = e; l += e; }
        l = wave_sum(l);
        linv[c] = 1.f / l;
    }
    __syncthreads();
    for (int j = lane; j < nk; j += 64) sm[j] = sm[j] * linv[0] - lam * sm[S + j] * linv[1];
    __syncthreads();
    float o0 = 0.f, o1 = 0.f;
    const float* vp = z + O_V + h * 128;
    for (int j = 0; j < nk; ++j) { const float a = sm[j]; const float* vr = vp + (size_t)j * INW; o0 = fmaf(a, vr[lane], o0); o1 = fmaf(a, vr[lane + 64], o1); }
    const float ms = wave_sum(o0 * o0 + o1 * o1) / 128.f;
    const float r = rsqrtf(ms + SUBLN_EPS) * (1.f - LAMBDA_INIT);
    yattn[(size_t)row * AW + h * 128 + lane] = o0 * r * subw[lane];
    yattn[(size_t)row * AW + h * 128 + lane + 64] = o1 * r * subw[lane + 64];
}

__global__ void k_merge(const float* __restrict__ z, float* __restrict__ ps, const float* __restrict__ pa) {
    const size_t i = (size_t)blockIdx.x * blockDim.x + threadIdx.x;
    if (i >= (size_t)S * D) return;
    const int c = (int)(i % D); const size_t row = i / D;
    const float gs = sigmoidf_(z[row * INW + O_GS + c]), ga = sigmoidf_(z[row * INW + O_GA + c]);
    ps[i] = gs * ps[i] + ga * pa[i];
}
__global__ void k_add(float* __restrict__ out, const float* __restrict__ a, const float* __restrict__ b, size_t n) {
    const size_t i = (size_t)blockIdx.x * blockDim.x + threadIdx.x;
    if (i < n) out[i] = a[i] + b[i];
}
__global__ void k_zero(float* __restrict__ p, size_t n) {
    const size_t i = (size_t)blockIdx.x * blockDim.x + threadIdx.x;
    if (i < n) p[i] = 0.f;
}

__global__ void __launch_bounds__(64) k_router(const float* __restrict__ x1, const float* __restrict__ w2, const float* __restrict__ rg, const float* __restrict__ re,
                                               float* __restrict__ h2, int* __restrict__ eid, float* __restrict__ egate) {
    const int row = blockIdx.x, lane = threadIdx.x;
    const float* xr = x1 + (size_t)row * D;
    float v[32]; float s = 0.f;
#pragma unroll
    for (int j = 0; j < 32; ++j) { v[j] = xr[lane + 64 * j]; s += v[j] * v[j]; }
    s = wave_sum(s);
    const float r = rsqrtf(s / D + NORM_EPS);
#pragma unroll
    for (int j = 0; j < 32; ++j) { v[j] = v[j] * r * w2[lane + 64 * j]; h2[(size_t)row * D + lane + 64 * j] = v[j]; }
    float gl[NGRP];
#pragma unroll
    for (int g = 0; g < NGRP; ++g) { float a = 0.f;
#pragma unroll
        for (int j = 0; j < 32; ++j) a = fmaf(v[j], rg[(size_t)(lane + 64 * j) * NGRP + g], a);
        gl[g] = wave_sum(a); }
    int gi = 0; float gm = gl[0];
#pragma unroll
    for (int g = 1; g < NGRP; ++g) if (gl[g] > gm) { gm = gl[g]; gi = g; }
    float gs = 0.f;
#pragma unroll
    for (int g = 0; g < NGRP; ++g) gs += expf(gl[g] - gm);
    const float gval = 1.f / gs;
    float el[EPG];
#pragma unroll
    for (int e = 0; e < EPG; ++e) { float a = 0.f;
#pragma unroll
        for (int j = 0; j < 32; ++j) a = fmaf(v[j], re[(size_t)(lane + 64 * j) * NE + gi * EPG + e], a);
        el[e] = wave_sum(a); }
    int i0 = 0; float v0 = el[0];
#pragma unroll
    for (int e = 1; e < EPG; ++e) if (el[e] > v0) { v0 = el[e]; i0 = e; }
    int i1 = -1; float v1 = -INFINITY;
#pragma unroll
    for (int e = 0; e < EPG; ++e) if (e != i0 && el[e] > v1) { v1 = el[e]; i1 = e; }
    const float e1 = expf(v1 - v0), den = 1.f + e1;
    if (lane == 0) {
        eid[2 * row] = gi * EPG + i0; eid[2 * row + 1] = gi * EPG + i1;
        egate[2 * row] = gval / den; egate[2 * row + 1] = gval * e1 / den;
    }
}

__global__ void __launch_bounds__(512) k_moe_up(const float* __restrict__ h2, const int* __restrict__ eid, const float* __restrict__ wg, const float* __restrict__ wu,
                                                float* __restrict__ act) {
    __shared__ float xs[D];
    const int slot = blockIdx.x, tok = slot >> 1, j = threadIdx.x;
    const int e = eid[slot];
    for (int d = j; d < D; d += 512) xs[d] = h2[(size_t)tok * D + d];
    __syncthreads();
    const float* g = wg + (size_t)e * D * DFF + j; const float* u = wu + (size_t)e * D * DFF + j;
    float a = 0.f, b = 0.f;
#pragma unroll 8
    for (int d = 0; d < D; ++d) { a = fmaf(xs[d], g[(size_t)d * DFF], a); b = fmaf(xs[d], u[(size_t)d * DFF], b); }
    act[(size_t)slot * DFF + j] = a * sigmoidf_(a) * b;
}
__global__ void __launch_bounds__(256) k_moe_down(const float* __restrict__ act, const int* __restrict__ eid, const float* __restrict__ egate,
                                                  const float* __restrict__ wd, float* __restrict__ out) {
    __shared__ float as[DFF];
    const int slot = blockIdx.x, tok = slot >> 1, t = threadIdx.x;
    const int e = eid[slot]; const float w = egate[slot];
    for (int d = t; d < DFF; d += 256) as[d] = act[(size_t)slot * DFF + d];
    __syncthreads();
    const float* wp = wd + (size_t)e * DFF * D;
    float acc[8] = {};
    for (int j = 0; j < DFF; ++j) { const float a = as[j];
#pragma unroll
        for (int i = 0; i < 8; ++i) acc[i] = fmaf(a, wp[(size_t)j * D + t + 256 * i], acc[i]); }
#pragma unroll
    for (int i = 0; i < 8; ++i) atomicAdd(&out[(size_t)tok * D + t + 256 * i], w * acc[i]);
}
}

extern "C" void kernel_launch(void* const* d_in, const int* in_sizes, int n_in, void* d_out, int out_size, void* d_ws, size_t ws_size, hipStream_t stream) {
    (void)in_sizes; (void)n_in; (void)out_size;
    const float* x = (const float*)d_in[0]; const int* pos = (const int*)d_in[1];
    const float* norm1_w = (const float*)d_in[2]; const float* w_in = (const float*)d_in[3];
    const float* lam_re = (const float*)d_in[4]; const float* lam_im = (const float*)d_in[5]; const float* log_dt = (const float*)d_in[6];
    const float* b_re = (const float*)d_in[7]; const float* b_im = (const float*)d_in[8]; const float* c_re = (const float*)d_in[9]; const float* c_im = (const float*)d_in[10];
    const float* ssm_d = (const float*)d_in[11]; const float* glu_w = (const float*)d_in[12]; const float* glu_b = (const float*)d_in[13];
    const float* lq1 = (const float*)d_in[14]; const float* lk1 = (const float*)d_in[15]; const float* lq2 = (const float*)d_in[16]; const float* lk2 = (const float*)d_in[17];
    const float* subw = (const float*)d_in[18]; const float* w_ps = (const float*)d_in[19]; const float* w_pa = (const float*)d_in[20]; const float* w_out = (const float*)d_in[21];
    const float* norm2_w = (const float*)d_in[22]; const float* rgw = (const float*)d_in[23]; const float* rew = (const float*)d_in[24];
    const float* ewg = (const float*)d_in[25]; const float* ewu = (const float*)d_in[26]; const float* ewd = (const float*)d_in[27]; const float* fnw = (const float*)d_in[28];
    float* out = (float*)d_out;
    const size_t MiB = 1u << 20;
    char* ws = (char*)d_ws;
    if (ws_size < 546 * MiB) { fprintf(stderr, "kernel_launch: workspace too small (%zu)\n", ws_size); return; }
    float* bufA = (float*)(ws);
    float* bufZ = (float*)(ws + 64 * MiB);
    float* bufC = (float*)(ws + 320 * MiB);
    float* bufD = (float*)(ws + 352 * MiB);
    float* bufE = (float*)(ws + 384 * MiB);
    float* bufF = (float*)(ws + 416 * MiB);
    float* bufG = (float*)(ws + 480 * MiB);
    int* eid = (int*)(ws + 544 * MiB); float* egate = (float*)(ws + 545 * MiB);

    k_rmsnorm<<<S, 64, 0, stream>>>(x, norm1_w, bufA);
    k_gemm<<<dim3(INW / 64, S / 64), 256, 0, stream>>>(bufA, D, w_in, INW, bufZ, INW, D);
    k_rope<<<(S * 32 * 32) / 256, 256, 0, stream>>>(bufZ, pos);
    k_ssm<<<NG, 64, 0, stream>>>(bufZ, lam_re, lam_im, log_dt, b_re, b_im, c_re, c_im, ssm_d, bufC);
    k_gemm<<<dim3(SSMW / 64, S / 64), 256, 0, stream>>>(bufC, SSMW, glu_w, SSMW, bufD, SSMW, SSMW);
    k_glu<<<(S * SSMW) / 256, 256, 0, stream>>>(bufC, bufD, glu_b, bufD);
    static bool attr = false;
    if (!attr) { attr = true; (void)hipFuncSetAttribute((const void*)k_attn, hipFuncAttributeMaxDynamicSharedMemorySize, 2 * S * 4); }
    k_attn<<<NH * S, 64, 2 * S * 4, stream>>>(bufZ, lq1, lk1, lq2, lk2, subw, bufE);
    k_gemm<<<dim3(D / 64, S / 64), 256, 0, stream>>>(bufD, SSMW, w_ps, D, bufF, D, SSMW);
    k_gemm<<<dim3(D / 64, S / 64), 256, 0, stream>>>(bufE, AW, w_pa, D, bufG, D, AW);
    k_merge<<<(S * D) / 256, 256, 0, stream>>>(bufZ, bufF, bufG);
    k_gemm<<<dim3(D / 64, S / 64), 256, 0, stream>>>(bufF, D, w_out, D, bufG, D, D);
    k_add<<<(S * D) / 256, 256, 0, stream>>>(bufF, x, bufG, (size_t)S * D);
    k_router<<<S, 64, 0, stream>>>(bufF, norm2_w, rgw, rew, bufA, eid, egate);
    k_moe_up<<<2 * S, 512, 0, stream>>>(bufA, eid, ewg, ewu, bufC);
    k_zero<<<(S * D) / 256, 256, 0, stream>>>(bufG, (size_t)S * D);
    k_moe_down<<<2 * S, 256, 0, stream>>>(bufC, eid, egate, ewd, bufG);
    k_add<<<(S * D) / 256, 256, 0, stream>>>(bufF, bufF, bufG, (size_t)S * D);
    k_rmsnorm<<<S, 64, 0, stream>>>(bufF, fnw, out);
}
```

```cpp
#include <hip/hip_runtime.h>
#include <cstdio>
#include <cstdint>
namespace pg8 {
#define PG8_LAS __attribute__((address_space(3)))
typedef unsigned short bf16_t;
typedef short bf16x8 __attribute__((ext_vector_type(8)));
typedef float f32x4 __attribute__((ext_vector_type(4)));
typedef unsigned u32x4 __attribute__((ext_vector_type(4)));
constexpr int BM = 256, BK = 64, HALF = 128, HTB = HALF * BK * 2  , STAGE_BYTES = 8 * HTB, NXCD = 8, WGM = 8;

__host__ __device__ __forceinline__ int lds_byte(int r, int c) { const int st = (r >> 4) * 2 + (c >> 5), rr = r & 15, cc = c & 31, ob = rr * 64 + cc * 2; return st * 1024 + (ob ^ (((ob >> 9) & 1) << 5)); }
__host__ __device__ __forceinline__ void stage_rc(int b, int& R, int& C) { const int st = b / 1024, sb = b % 1024, swz = sb ^ (((sb >> 9) & 1) << 5); R = (st >> 1) * 16 + swz / 64; C = (st & 1) * 32 + (swz % 64) / 2; }
__host__ __device__ __forceinline__ int perm32(int rho) { const int n = rho >> 4, i = rho & 15; return 8 * (i >> 2) + 4 * n + (i & 3); }

struct Unit { int pm, pn; };
struct Gemm { const bf16_t* A; const bf16_t* Bt; int M, N, K; };

struct StaticOrder {
    int nM, nN, nwg, G, c;
    __host__ __device__ void init(int M, int N, int G_, int c_) { nM = M / BM; nN = N / BM; nwg = nM * nN; G = G_; c = c_; }
    __host__ __device__ bool next(int i, Unit& u) const {
        const long L = (long)i * G + c; if (L >= nwg) return false;
        int wgid = (int)L; { const int q = nwg / NXCD, r = nwg % NXCD, xcd = wgid % NXCD, off = wgid / NXCD; wgid = (xcd < r ? xcd * (q + 1) : r * (q + 1) + (xcd - r) * q) + off; }
        const int nig = WGM * nN, gid = wgid / nig, fm = gid * WGM, gsz = (nM - fm) < WGM ? (nM - fm) : WGM;
        u.pm = fm + ((wgid % nig) % gsz); u.pn = (wgid % nig) / gsz; return true;
    }
    __device__ __forceinline__ void a_ready(const Unit&) const {}
    __device__ __forceinline__ void done(const Unit&) const {}
};

__device__ __forceinline__ unsigned cvt_pk_bf16(float lo, float hi) { unsigned r; asm volatile("v_cvt_pk_bf16_f32 %0, %1, %2" : "=v"(r) : "v"(lo), "v"(hi)); return r; }
typedef float f32x2 __attribute__((ext_vector_type(2)));
typedef unsigned u32x2 __attribute__((ext_vector_type(2)));
__device__ __forceinline__ float fsig(float x) { return __builtin_amdgcn_rcpf(1.f + __builtin_amdgcn_exp2f(-1.4426950408889634f * x)); }
__device__ __forceinline__ float bf_lo(unsigned w) { return __builtin_bit_cast(float, w << 16); }
__device__ __forceinline__ float bf_hi(unsigned w) { return __builtin_bit_cast(float, w & 0xffff0000u); }
__device__ __forceinline__ void unpack8(const u32x4 w, f32x4& a, f32x4& b) { a = (f32x4){bf_lo(w.x), bf_hi(w.x), bf_lo(w.y), bf_hi(w.y)}; b = (f32x4){bf_lo(w.z), bf_hi(w.z), bf_lo(w.w), bf_hi(w.w)}; }
__device__ __forceinline__ u32x4 pack8(const f32x4 a, const f32x4 b) { u32x4 w; w.x = cvt_pk_bf16(a[0], a[1]); w.y = cvt_pk_bf16(a[2], a[3]); w.z = cvt_pk_bf16(b[0], b[1]); w.w = cvt_pk_bf16(b[2], b[3]); return w; }
#define EPI_ROWS(...) _Pragma("unroll") for (int ai = 0; ai < 2; ++ai) _Pragma("unroll") for (int m = 0; m < 4; ++m) { const int row = row0 + ai * HALF + m * 16; __VA_ARGS__ }

struct EpiInProj {
    static constexpr bool PERM = true, AFTER_DRAIN = false;
    bf16_t* Z; const float* rope;
    __device__ __forceinline__ void operator()(const f32x4 (&acc)[2][2][4][2], const Unit& u, int wr, int wc, int fr, int fq) const {
        const int row0 = u.pm * BM + wr * 64 + fr, col0 = u.pn * BM + wc * 32 + 8 * fq, kind = u.pn >> 2;
        const int i4 = ((wc & 1) * 4 + fq) * 4;
        EPI_ROWS(
            bf16_t* rowp = Z + (size_t)row * 8192 + col0;
            f32x4 cs = (f32x4){1.f, 1.f, 1.f, 1.f}, sn = (f32x4){0.f, 0.f, 0.f, 0.f};
            if (kind == 1 || kind == 2) { cs = *(const f32x4*)(rope + (size_t)row * 64 + i4); sn = *(const f32x4*)(rope + (size_t)row * 64 + 32 + i4); }
            _Pragma("unroll") for (int bj = 0; bj < 2; ++bj) {
                f32x4 v0 = acc[ai][bj][m][0], v1 = acc[ai][bj][m][1];
                if (kind == 1 || kind == 2) { const f32x4 lo = v0 * cs - v1 * sn, hi = v1 * cs + v0 * sn; v0 = lo; v1 = hi; }
                else if (kind >= 4) { _Pragma("unroll") for (int e = 0; e < 4; ++e) { v0[e] = fsig(v0[e]); v1[e] = fsig(v1[e]); } }
                *(u32x4*)(rowp + bj * HALF) = pack8(v0, v1); }
        )
    }
};
struct EpiGlu {
    static constexpr bool PERM = true, AFTER_DRAIN = false;
    const bf16_t* Yp; const float* bias; bf16_t* O;
    __device__ __forceinline__ void operator()(const f32x4 (&acc)[2][2][4][2], const Unit& u, int wr, int wc, int fr, int fq) const {
        const int row0 = u.pm * BM + wr * 64 + fr, col0 = u.pn * BM + wc * 32 + 8 * fq;
        EPI_ROWS(
            _Pragma("unroll") for (int bj = 0; bj < 2; ++bj) { const size_t off = (size_t)row * 1024 + col0 + bj * HALF;
                f32x4 y0, y1; unpack8(*(const u32x4*)(Yp + off), y0, y1);
                const f32x4 b0 = *(const f32x4*)(bias + col0 + bj * HALF), b1 = *(const f32x4*)(bias + col0 + bj * HALF + 4);
                f32x4 v0 = acc[ai][bj][m][0] + b0, v1 = acc[ai][bj][m][1] + b1;
                _Pragma("unroll") for (int e = 0; e < 4; ++e) { v0[e] = y0[e] * fsig(v0[e]); v1[e] = y1[e] * fsig(v1[e]); }
                *(u32x4*)(O + off) = pack8(v0, v1); }
        )
    }
};
template <bool FIRST> struct EpiProj {
    static constexpr bool PERM = true, AFTER_DRAIN = false;
    const bf16_t* Z; int gcol; bf16_t* T1; bf16_t* MG;
    __device__ __forceinline__ void operator()(const f32x4 (&acc)[2][2][4][2], const Unit& u, int wr, int wc, int fr, int fq) const {
        const int row0 = u.pm * BM + wr * 64 + fr, col0 = u.pn * BM + wc * 32 + 8 * fq;
        EPI_ROWS(
            _Pragma("unroll") for (int bj = 0; bj < 2; ++bj) { const size_t off = (size_t)row * 2048 + col0 + bj * HALF;
                f32x4 g0, g1; unpack8(*(const u32x4*)(Z + (size_t)row * 8192 + gcol + col0 + bj * HALF), g0, g1);
                f32x4 v0 = acc[ai][bj][m][0] * g0, v1 = acc[ai][bj][m][1] * g1;
                if (FIRST) { *(u32x4*)(T1 + off) = pack8(v0, v1); }
                else { f32x4 t0, t1; unpack8(*(const u32x4*)(T1 + off), t0, t1); *(u32x4*)(MG + off) = pack8(v0 + t0, v1 + t1); } }
        )
    }
};
struct EpiOut {
    static constexpr bool PERM = false, AFTER_DRAIN = false;
    const float* X; float* O;
    __device__ __forceinline__ void operator()(const f32x4 (&acc)[2][2][4][2], const Unit& u, int wr, int wc, int fr, int fq) const {
        const int row0 = u.pm * BM + wr * 64 + fr, col0 = u.pn * BM + wc * 32 + 4 * fq;
        EPI_ROWS(
            _Pragma("unroll") for (int bj = 0; bj < 2; ++bj) _Pragma("unroll") for (int n = 0; n < 2; ++n) { const size_t off = (size_t)row * 2048 + col0 + bj * HALF + n * 16;
                *(f32x4*)(O + off) = *(const f32x4*)(X + off) + acc[ai][bj][m][n]; }
        )
    }
};
struct EpiMoeUp {
    static constexpr bool PERM = true, AFTER_DRAIN = false;
    bf16_t* ACT;
    __device__ __forceinline__ void operator()(const f32x4 (&acc)[2][2][4][2], const Unit& u, int wr, int wc, int fr, int fq) const {
        const int row0 = u.pm * BM + wr * 64 + fr, col0 = (u.pn & 3) * HALF + wc * 32 + 8 * fq;
        EPI_ROWS(
            f32x4 v0, v1;
            _Pragma("unroll") for (int e = 0; e < 4; ++e) { const float g0 = acc[ai][0][m][0][e], g1 = acc[ai][0][m][1][e];
                v0[e] = g0 * fsig(g0) * acc[ai][1][m][0][e]; v1[e] = g1 * fsig(g1) * acc[ai][1][m][1][e]; }
            *(u32x4*)(ACT + (size_t)row * 512 + col0) = pack8(v0, v1);
        )
    }
};
struct EpiMoeDown {
    static constexpr bool PERM = true, AFTER_DRAIN = false;
    const int* slot_of; const float* slot_w; bf16_t* Y;
    __device__ __forceinline__ void operator()(const f32x4 (&acc)[2][2][4][2], const Unit& u, int wr, int wc, int fr, int fq) const {
        const int row0 = u.pm * BM + wr * 64 + fr, col0 = (u.pn & 7) * BM + wc * 32 + 8 * fq;
        EPI_ROWS(
            const int slot = slot_of[row]; const float w = slot_w[row];
            if (slot >= 0) { _Pragma("unroll") for (int bj = 0; bj < 2; ++bj) *(u32x4*)(Y + (size_t)slot * 2048 + col0 + bj * HALF) = pack8(acc[ai][bj][m][0] * w, acc[ai][bj][m][1] * w); }
        )
    }
};
struct MoeOrder {
    const PG8_LAS int* rt_start; int ncol, G, c;
    __device__ __forceinline__ bool next(int i, Unit& u) const {
        const int L = i * G + c, total = rt_start[32] * ncol; if (L >= total) return false;
        const int rt = L / ncol, ct = L - rt * ncol; int e = 0;
#pragma unroll
        for (int k = 1; k < 32; ++k) e += (rt >= rt_start[k]) ? 1 : 0;
        u.pm = rt; u.pn = e * ncol + ct; return true;
    }
    __device__ __forceinline__ void a_ready(const Unit&) const {}
    __device__ __forceinline__ void done(const Unit&) const {}
};
template <class Epi, class Sched, bool ALIGN_EPI = false, bool SP2 = false>
__device__ __forceinline__ void gemm_phase(PG8_LAS unsigned char* lds, const Gemm g, const Sched& S, const Epi& E) {
    const int tid = threadIdx.x, wid = __builtin_amdgcn_readfirstlane(tid >> 6), lane = tid & 63, wr = wid >> 2, wc = wid & 3, fr = lane & 15, fq = lane >> 4;
    const int K = g.K, nt = K / BK;
    unsigned voffA[2], voffB[2];
#pragma unroll
    for (int i = 0; i < 2; ++i) { int R, C; stage_rc(tid * 16 + i * 8192, R, C); const int Rb = Epi::PERM ? ((R & ~31) + perm32(R & 31)) : R;
        voffA[i] = (unsigned)(R * K + C) * 2u; voffB[i] = (unsigned)(Rb * K + C) * 2u; }
    const size_t kstep = (size_t)(BK * 2);
    const size_t hstep = (size_t)HALF * K * 2;
    const size_t tstep = 2 * hstep;
    const unsigned ldsw = (unsigned)wid * 1024u;
    const int aoff = lds_byte(wr * 64 + fr, fq * 8), boff = lds_byte(wc * 32 + fr, fq * 8);
#define PG8_SA(b, h) (((b) * 2 + (h)) * HTB)
#define PG8_SB(b, h) ((4 + (b) * 2 + (h)) * HTB)
#define PG8_STAGE(bufoff, gbase, voff) do { _Pragma("unroll") for (int _i = 0; _i < 2; ++_i) \
        __builtin_amdgcn_global_load_lds((const unsigned*)((const char*)(gbase) + (voff)[_i]), (PG8_LAS unsigned*)(lds + (bufoff) + ldsw + _i * 8192), 16, 0, 0); } while (0)
#define PG8_LDA(dst, b, h) do { _Pragma("unroll") for (int m = 0; m < 4; ++m) _Pragma("unroll") for (int k = 0; k < 2; ++k) dst[m][k] = *(const PG8_LAS bf16x8*)(lds + PG8_SA(b, h) + aoff + m * 2048 + k * 1024); } while (0)
#define PG8_LDB(dst, b, h) do { _Pragma("unroll") for (int n = 0; n < 2; ++n) _Pragma("unroll") for (int k = 0; k < 2; ++k) dst[n][k] = *(const PG8_LAS bf16x8*)(lds + PG8_SB(b, h) + boff + n * 2048 + k * 1024); } while (0)
#define PG8_MMA(ai, bj, At, Bt) do { __builtin_amdgcn_s_setprio(1); _Pragma("unroll") for (int m = 0; m < 4; ++m) _Pragma("unroll") for (int n = 0; n < 2; ++n) _Pragma("unroll") for (int k = 0; k < 2; ++k) \
        acc[ai][bj][m][n] = __builtin_amdgcn_mfma_f32_16x16x32_bf16(Bt[n][k], At[m][k], acc[ai][bj][m][n], 0, 0, 0); __builtin_amdgcn_s_setprio(0); } while (0)
#define PG8_WAIT_V(n) asm volatile("s_waitcnt vmcnt(" #n ")" ::: "memory")
#define PG8_WAIT_L(n) asm volatile("s_waitcnt lgkmcnt(" #n ")" ::: "memory")
#define PG8_BAR __builtin_amdgcn_s_barrier()
#define PG8_SCHED __builtin_amdgcn_sched_barrier(0)
    Unit cur, nxt; int ui = 0;
    if (!S.next(0, cur)) return;
    f32x4 acc[2][2][4][2];
#pragma unroll
    for (int a = 0; a < 2; ++a)
#pragma unroll
        for (int b = 0; b < 2; ++b)
#pragma unroll
            for (int m = 0; m < 4; ++m)
#pragma unroll
                for (int n = 0; n < 2; ++n) acc[a][b][m][n] = (f32x4){0.f, 0.f, 0.f, 0.f};
    bf16x8 At[4][2], B0[2][2], B1[2][2];
    const char* cA = (const char*)g.A + (size_t)cur.pm * tstep; const char* cB = (const char*)g.Bt + (size_t)cur.pn * tstep;
    S.a_ready(cur);
    if constexpr (SP2) {
        PG8_STAGE(PG8_SB(0, 0), cB, voffB); PG8_STAGE(PG8_SB(0, 1), cB + hstep, voffB); PG8_STAGE(PG8_SA(0, 0), cA, voffA); PG8_STAGE(PG8_SA(0, 1), cA + hstep, voffA);
        if (wr == 1) PG8_BAR;
        PG8_WAIT_V(2); PG8_BAR;
        PG8_STAGE(PG8_SB(1, 0), cB + kstep, voffB); PG8_STAGE(PG8_SA(1, 0), cA + kstep, voffA); PG8_STAGE(PG8_SB(1, 1), cB + hstep + kstep, voffB);
        PG8_WAIT_V(6); PG8_BAR;
    } else {
        PG8_STAGE(PG8_SB(0, 0), cB, voffB); PG8_STAGE(PG8_SA(0, 0), cA, voffA); PG8_STAGE(PG8_SB(0, 1), cB + hstep, voffB); PG8_STAGE(PG8_SA(0, 1), cA + hstep, voffA);
        if (wr == 1) PG8_BAR;
        PG8_WAIT_V(4); PG8_BAR;
        PG8_STAGE(PG8_SB(1, 0), cB + kstep, voffB); PG8_STAGE(PG8_SA(1, 0), cA + kstep, voffA); PG8_STAGE(PG8_SB(1, 1), cB + hstep + kstep, voffB);
        PG8_WAIT_V(6); PG8_BAR;
    }
    for (;;) {
        const bool has_next = S.next(ui + 1, nxt);
        const char* nA = has_next ? (const char*)g.A + (size_t)nxt.pm * tstep : cA; const char* nB = has_next ? (const char*)g.Bt + (size_t)nxt.pn * tstep : cB;
        for (int t = 0; t < nt; t += 2) {
            const bool last = (t == nt - 2);
            const char* a1 = cA + (size_t)(t + 1) * kstep;
            const char* a2 = last ? nA : cA + (size_t)(t + 2) * kstep; const char* b2 = last ? nB : cB + (size_t)(t + 2) * kstep;
            const char* a3 = a2 + kstep; const char* b3 = b2 + kstep;
            if (last && has_next) S.a_ready(nxt);
            if constexpr (SP2) {
            PG8_LDB(B0, 0, 0); PG8_LDB(B1, 0, 1); PG8_SCHED; PG8_LDA(At, 0, 0); PG8_STAGE(PG8_SA(1, 1), a1 + hstep, voffA);
            PG8_WAIT_V(8); PG8_WAIT_L(0); PG8_BAR; PG8_MMA(0, 0, At, B0); PG8_MMA(0, 1, At, B1); PG8_BAR; PG8_SCHED;
            PG8_LDA(At, 0, 1); PG8_STAGE(PG8_SB(0, 0), b2, voffB); PG8_STAGE(PG8_SB(0, 1), b2 + hstep, voffB); PG8_STAGE(PG8_SA(0, 0), a2, voffA);
            PG8_WAIT_V(8); PG8_WAIT_L(0); PG8_BAR; PG8_MMA(1, 0, At, B0); PG8_MMA(1, 1, At, B1); PG8_BAR; PG8_SCHED;
            PG8_LDB(B0, 1, 0); PG8_LDB(B1, 1, 1); PG8_SCHED; PG8_LDA(At, 1, 0); PG8_STAGE(PG8_SA(0, 1), a2 + hstep, voffA);
            PG8_WAIT_V(8); PG8_WAIT_L(0); PG8_BAR; PG8_MMA(0, 0, At, B0); PG8_MMA(0, 1, At, B1); PG8_BAR; PG8_SCHED;
            PG8_LDA(At, 1, 1); PG8_STAGE(PG8_SB(1, 0), b3, voffB); PG8_STAGE(PG8_SB(1, 1), b3 + hstep, voffB); PG8_STAGE(PG8_SA(1, 0), a3, voffA);
            PG8_WAIT_V(8); PG8_WAIT_L(0); PG8_BAR; PG8_MMA(1, 0, At, B0); PG8_MMA(1, 1, At, B1); PG8_BAR; PG8_SCHED;
            } else {
            PG8_LDB(B0, 0, 0); PG8_SCHED; PG8_LDA(At, 0, 0); PG8_STAGE(PG8_SA(1, 1), a1 + hstep, voffA);
            PG8_WAIT_L(8); PG8_BAR; PG8_WAIT_L(0); PG8_MMA(0, 0, At, B0); PG8_BAR; PG8_SCHED;
            PG8_LDB(B1, 0, 1); PG8_STAGE(PG8_SB(0, 0), b2, voffB);
            PG8_BAR; PG8_WAIT_L(0); PG8_MMA(0, 1, At, B1); PG8_BAR;
            PG8_LDA(At, 0, 1); PG8_STAGE(PG8_SA(0, 0), a2, voffA);
            PG8_BAR; PG8_WAIT_L(0); PG8_MMA(1, 0, At, B0); PG8_BAR; PG8_SCHED;
            PG8_STAGE(PG8_SB(0, 1), b2 + hstep, voffB);
            PG8_WAIT_V(6); PG8_BAR; PG8_MMA(1, 1, At, B1); PG8_BAR;
            PG8_LDB(B0, 1, 0); PG8_SCHED; PG8_LDA(At, 1, 0); PG8_STAGE(PG8_SA(0, 1), a2 + hstep, voffA);
            PG8_WAIT_L(8); PG8_BAR; PG8_WAIT_L(0); PG8_MMA(0, 0, At, B0); PG8_BAR; PG8_SCHED;
            PG8_LDB(B1, 1, 1); PG8_STAGE(PG8_SB(1, 0), b3, voffB);
            PG8_BAR; PG8_WAIT_L(0); PG8_MMA(0, 1, At, B1); PG8_BAR;
            PG8_LDA(At, 1, 1); PG8_STAGE(PG8_SA(1, 0), a3, voffA);
            PG8_BAR; PG8_WAIT_L(0); PG8_MMA(1, 0, At, B0); PG8_BAR; PG8_SCHED;
            PG8_STAGE(PG8_SB(1, 1), b3 + hstep, voffB);
            PG8_WAIT_V(6); PG8_BAR; PG8_MMA(1, 1, At, B1); PG8_BAR;
            }
        }
        if constexpr (ALIGN_EPI) { if (wr == 0) PG8_BAR; }
        if constexpr (!Epi::AFTER_DRAIN) { E(acc, cur, wr, wc, fr, fq); S.done(cur); }
        if (!has_next) break;
#pragma unroll
        for (int a = 0; a < 2; ++a)
#pragma unroll
            for (int b = 0; b < 2; ++b)
#pragma unroll
                for (int m = 0; m < 4; ++m)
#pragma unroll
                    for (int n = 0; n < 2; ++n) acc[a][b][m][n] = (f32x4){0.f, 0.f, 0.f, 0.f};
        cur = nxt; cA = nA; cB = nB; ++ui;
        if constexpr (ALIGN_EPI) { if (wr == 1) PG8_BAR; }
    }
    PG8_WAIT_V(0);
    if constexpr (!ALIGN_EPI) { if (wr == 0) PG8_BAR; }
    PG8_BAR;
    if constexpr (Epi::AFTER_DRAIN) { E.fused(acc, cur, wr, wc, fr, fq, lds, wid, lane); S.done(cur); }
#undef PG8_SA
#undef PG8_SB
#undef PG8_STAGE
#undef PG8_LDA
#undef PG8_LDB
#undef PG8_MMA
#undef PG8_WAIT_V
#undef PG8_WAIT_L
#undef PG8_BAR
#undef PG8_SCHED
}
}

namespace att {
#define ATT_LAS __attribute__((address_space(3)))
typedef unsigned short bf16_t;
typedef short bf16x8 __attribute__((ext_vector_type(8)));
typedef short s16x4 __attribute__((ext_vector_type(4)));
typedef float f32x16 __attribute__((ext_vector_type(16)));
typedef float f32x4 __attribute__((ext_vector_type(4)));
typedef unsigned u32x4 __attribute__((ext_vector_type(4)));
constexpr int NW = 8, QBLK = 32, KVBLK = 64, QB = 128, PITCH = 8192;
constexpr int SHM_V = KVBLK * 128 * 2, SHM_K = KVBLK * 128 * 2;
constexpr int LDS_BYTES = 2 * SHM_V + 2 * SHM_K + NW * 64 * 4;
constexpr float SCALE = 0.125f, THR = 8.f;
#define KSWZ(row, colB) ((row) * 256 + ((colB) ^ (((row) & 7) << 4)))
#define SBAR() __builtin_amdgcn_sched_barrier(0)
__device__ __forceinline__ int v_st(int k, int c) { const int kk = (k & ~0xC) | ((k & 4) << 1) | ((k & 8) >> 1); return ((kk >> 3) * 4 + (c >> 5)) * 512 + ((kk & 7) * 32 + (c & 31)) * 2; }
__device__ __forceinline__ int v_rd_base(int lane) { return ((lane & 3) << 3) | (((lane >> 2) & 3) << 6) | (((lane >> 4) & 1) << 5) | (((lane >> 5) & 1) << 8); }
constexpr int v_rd_off(int d0, int ks, int half) { return d0 * 512 + ks * 4096 + half * 2048; }
__device__ __forceinline__ int crow(int r, int hi) { return (r & 3) + 8 * (r >> 2) + 4 * hi; }
__device__ __forceinline__ unsigned cvtpk(float lo, float hi) { unsigned r; asm volatile("v_cvt_pk_bf16_f32 %0, %1, %2" : "=v"(r) : "v"(lo), "v"(hi)); return r; }
__device__ __forceinline__ void mask_tile(f32x16& p0, f32x16& p1, int dq) {
    const float NEG = -__builtin_inff();
#pragma unroll
    for (int r = 0; r < 16; ++r) { const int c = (r & 3) + 8 * (r >> 2); if (dq - c < 0) p0[r] = NEG; if (dq - c - 32 < 0) p1[r] = NEG; }
}
__device__ __forceinline__ void partialSM(f32x16& p0, f32x16& p1, float& m_reg, float& mn, float& alpha) {
    float pmax = p0[0];
#pragma unroll
    for (int r = 1; r < 16; ++r) pmax = fmaxf(pmax, p0[r]);
#pragma unroll
    for (int r = 0; r < 16; ++r) pmax = fmaxf(pmax, p1[r]);
    { auto rr = __builtin_amdgcn_permlane32_swap(__float_as_uint(pmax), __float_as_uint(pmax), false, false);
      pmax = fmaxf(__uint_as_float(rr[0]), __uint_as_float(rr[1])); }
    constexpr float C2 = 1.4426950408889634f * SCALE;
    if (__builtin_expect(__all((pmax - m_reg) * SCALE <= THR), 1)) { mn = m_reg; alpha = 1.f; }
    else { mn = fmaxf(m_reg, pmax); alpha = __builtin_amdgcn_exp2f((m_reg - mn) * C2); m_reg = mn; }
    const float mnL = -mn * C2;
#pragma unroll
    for (int r = 0; r < 16; ++r) p0[r] = fmaf(p0[r], C2, mnL);
#pragma unroll
    for (int r = 0; r < 16; ++r) p1[r] = fmaf(p1[r], C2, mnL);
#pragma unroll
    for (int r = 0; r < 16; ++r) p0[r] = __builtin_amdgcn_exp2f(p0[r]);
}
__device__ __forceinline__ void finishSM(f32x16& p0, f32x16& p1, float alpha, float& l_reg, bf16x8& pa0, bf16x8& pa1, bf16x8& pa2, bf16x8& pa3) {
#pragma unroll
    for (int r = 0; r < 16; ++r) p1[r] = __builtin_amdgcn_exp2f(p1[r]);
    float ps = 0;
#pragma unroll
    for (int r = 0; r < 16; ++r) ps += p0[r];
#pragma unroll
    for (int r = 0; r < 16; ++r) ps += p1[r];
    { auto rr = __builtin_amdgcn_permlane32_swap(__float_as_uint(ps), __float_as_uint(ps), false, false);
      ps = __uint_as_float(rr[0]) + __uint_as_float(rr[1]); }
    l_reg = l_reg * alpha + ps;
#define PK4(P, B_, OUT) do { unsigned a0 = cvtpk(P[B_+0], P[B_+1]), a1 = cvtpk(P[B_+2], P[B_+3]);                          \
        unsigned b0 = cvtpk(P[B_+4], P[B_+5]), b1 = cvtpk(P[B_+6], P[B_+7]);                                             \
        auto r0 = __builtin_amdgcn_permlane32_swap(a0, b0, false, false); auto r1 = __builtin_amdgcn_permlane32_swap(a1, b1, false, false); \
        u32x4 w = {r0[0], r1[0], r0[1], r1[1]}; OUT = __builtin_bit_cast(bf16x8, w); } while (0)
    PK4(p0, 0, pa0); PK4(p0, 8, pa1); PK4(p1, 0, pa2); PK4(p1, 8, pa3);
#undef PK4
}
template <int KB>
__device__ __forceinline__ void qkt(f32x16& p0, f32x16& p1, const ATT_LAS char* K_lds, int r32, int hi, int cofs, const bf16x8* qr) {
    p0 = f32x16{}; p1 = f32x16{};
#pragma unroll
    for (int d0 = 0; d0 < 4; ++d0) { const ATT_LAS char* a = K_lds + KB * SHM_K + KSWZ(r32, (d0 * 16 + hi * 8) * 2) + cofs;
        const bf16x8 b0 = *reinterpret_cast<const ATT_LAS bf16x8*>(a);
        const bf16x8 b1 = *reinterpret_cast<const ATT_LAS bf16x8*>(a + 32 * 256);
        p0 = __builtin_amdgcn_mfma_f32_32x32x16_bf16(b0, qr[d0], p0, 0, 0, 0);
        p1 = __builtin_amdgcn_mfma_f32_32x32x16_bf16(b1, qr[d0], p1, 0, 0, 0); }
}
template <int VB>
__device__ __forceinline__ void pv_tile(f32x16* o, int vb0, bf16x8 pa0, bf16x8 pa1, bf16x8 pa2, bf16x8 pa3) {
#define TRRD(dst, off) asm volatile("ds_read_b64_tr_b16 %0, %1 offset:%2" : "=&v"(dst) : "v"(vb0), "i"(off) : "memory")
#define PV_D0(d0) do { s16x4 l0, l1, l2, l3, h0, h1, h2, h3; constexpr int b_ = VB * SHM_V + v_rd_off(d0, 0, 0); \
        TRRD(l0, b_); TRRD(h0, b_ + 2048); TRRD(l1, b_ + 4096); TRRD(h1, b_ + 6144); TRRD(l2, b_ + 8192); TRRD(h2, b_ + 10240); TRRD(l3, b_ + 12288); TRRD(h3, b_ + 14336); \
        asm volatile("s_waitcnt lgkmcnt(0)" ::: "memory"); SBAR();   \
        o[d0] = __builtin_amdgcn_mfma_f32_32x32x16_bf16(pa0, (bf16x8){l0[0], l0[1], l0[2], l0[3], h0[0], h0[1], h0[2], h0[3]}, o[d0], 0, 0, 0);   \
        o[d0] = __builtin_amdgcn_mfma_f32_32x32x16_bf16(pa1, (bf16x8){l1[0], l1[1], l1[2], l1[3], h1[0], h1[1], h1[2], h1[3]}, o[d0], 0, 0, 0);   \
        o[d0] = __builtin_amdgcn_mfma_f32_32x32x16_bf16(pa2, (bf16x8){l2[0], l2[1], l2[2], l2[3], h2[0], h2[1], h2[2], h2[3]}, o[d0], 0, 0, 0);   \
        o[d0] = __builtin_amdgcn_mfma_f32_32x32x16_bf16(pa3, (bf16x8){l3[0], l3[1], l3[2], l3[3], h3[0], h3[1], h3[2], h3[3]}, o[d0], 0, 0, 0); } while (0)
    PV_D0(0); PV_D0(1); PV_D0(2); PV_D0(3);
#undef PV_D0
#undef TRRD
}
__device__ __forceinline__ void attn_block(int h, int qb, const bf16_t* Z, int ZQ, int ZK, int ZV, float lam, const float* subw, bf16_t* YA, ATT_LAS char* lds) {
    const int tid = threadIdx.x, wid = __builtin_amdgcn_readfirstlane(tid >> 6), lane = tid & 63, r32 = lane & 31, hi = lane >> 5;
    const int wq = wid & 3, cm = wid >> 2, cofs = cm * 128;
    const int P0 = qb * QB, NT = (P0 + QB - 1) / KVBLK + 1;
    const int qlo = P0 + wq * QBLK, qm = qlo + r32 - 4 * hi;
    ATT_LAS char* V_lds = lds; ATT_LAS char* K_lds = lds + 2 * SHM_V;
    ATT_LAS float* ws = (ATT_LAS float*)(lds + 2 * SHM_V + 2 * SHM_K) + wid * 64; ATT_LAS float* li_l = ws; ATT_LAS float* al_l = ws + 32;
    float m_reg = -1e30f, l_reg = 0; f32x16 o[4] = {};
    const int sr = tid >> 4, sc = (tid & 15) * 8, vst0 = v_st(sr, sc), vst1 = v_st(32 + sr, sc), kws = KSWZ(sr, sc * 2);
    const int vb0 = (int)(unsigned)(uintptr_t)V_lds + v_rd_base(lane);
    const bf16_t* Kh = Z + ZK + h * 128; const bf16_t* Vh = Z + ZV + h * 128;
    bf16x8 st_v0, st_v1, st_k0, st_k1;
#define ROW(p, k0, rr) ((p) + (size_t)((k0) + (rr)) * PITCH + sc)
#define VMW() asm volatile("s_waitcnt vmcnt(0)" ::: "memory")
#define SLOAD_H(k0) do { st_v0 = *(const bf16x8*)ROW(Vh, k0, sr); st_v1 = *(const bf16x8*)ROW(Vh, k0, 32 + sr); st_k0 = *(const bf16x8*)ROW(Kh, k0, sr); st_k1 = *(const bf16x8*)ROW(Kh, k0, 32 + sr); } while (0)
#define SWRITE_H(bf) do { *(ATT_LAS bf16x8*)(V_lds + (bf) * SHM_V + vst0) = st_v0; *(ATT_LAS bf16x8*)(V_lds + (bf) * SHM_V + vst1) = st_v1; \
                          *(ATT_LAS bf16x8*)(K_lds + (bf) * SHM_K + kws) = st_k0; *(ATT_LAS bf16x8*)(K_lds + (bf) * SHM_K + kws + 32 * 256) = st_k1; } while (0)
#define RESC(a) do { if (__any((a) < 1.f)) { if (hi == 0) al_l[r32] = (a); asm volatile("s_waitcnt lgkmcnt(0)" ::: "memory");              \
                     _Pragma("unroll") for (int d_ = 0; d_ < 4; ++d_) _Pragma("unroll") for (int r = 0; r < 16; ++r) o[d_][r] *= al_l[crow(r, hi)]; } } while (0)
#define KBASE(t) ((t) * KVBLK)
#define MASKT(P0_, P1_, t) do { const int kb_ = KBASE(t); if (kb_ + KVBLK - 1 > qlo) mask_tile(P0_, P1_, qm - kb_); } while (0)
    bf16x8 qr[4];
    SLOAD_H(0);
#pragma unroll
    for (int d0 = 0; d0 < 4; ++d0) qr[d0] = *(const bf16x8*)(Z + ZQ + h * 128 + cm * 64 + (size_t)(qlo + r32) * PITCH + d0 * 16 + hi * 8);
    VMW(); SWRITE_H(0);
    __syncthreads();
    f32x16 pA0, pA1, pB0, pB1; float mnA, mnB, alA, alB; bf16x8 pa0, pa1, pa2, pa3;
    if (NT > 1) SLOAD_H(KBASE(1));
    SBAR(); qkt<0>(pA0, pA1, K_lds, r32, hi, cofs, qr);
    MASKT(pA0, pA1, 0); partialSM(pA0, pA1, m_reg, mnA, alA);
    if (NT > 1) { VMW(); SWRITE_H(1); }
    __syncthreads();
#define HALF_STEP(PX0, PX1, mnX, alX, PY0, PY1, alY, t, KB, VB, SB) do {                                                      \
        SBAR(); qkt<KB>(PX0, PX1, K_lds, r32, hi, cofs, qr);                                                                   \
        finishSM(PY0, PY1, alY, l_reg, pa0, pa1, pa2, pa3); SBAR();                                                           \
        if ((t) + 1 < NT) { SLOAD_H(KBASE((t) + 1)); SBAR(); }                                                                \
        pv_tile<VB>(o, vb0, pa0, pa1, pa2, pa3); MASKT(PX0, PX1, (t)); partialSM(PX0, PX1, m_reg, mnX, alX);                  \
        __syncthreads();                                                                                                      \
        if ((t) + 1 < NT) { VMW(); SWRITE_H(SB); }                                                                            \
        RESC(alX); __syncthreads(); } while (0)
    for (int t = 1; t + 1 < NT; t += 2) {
        HALF_STEP(pB0, pB1, mnB, alB, pA0, pA1, alA, t, 1, 0, 0);
        HALF_STEP(pA0, pA1, mnA, alA, pB0, pB1, alB, t + 1, 0, 1, 1);
    }
    const bool even = (NT & 1) == 0;
    if (even) { SBAR(); qkt<1>(pB0, pB1, K_lds, r32, hi, cofs, qr); SBAR(); }
    finishSM(pA0, pA1, alA, l_reg, pa0, pa1, pa2, pa3); SBAR();
    pv_tile<0>(o, vb0, pa0, pa1, pa2, pa3);
    if (even) { MASKT(pB0, pB1, NT - 1); partialSM(pB0, pB1, m_reg, mnB, alB); RESC(alB);
        finishSM(pB0, pB1, alB, l_reg, pa0, pa1, pa2, pa3); SBAR(); pv_tile<1>(o, vb0, pa0, pa1, pa2, pa3); }
    if (hi == 0) li_l[r32] = l_reg; asm volatile("s_waitcnt lgkmcnt(0)" ::: "memory");
    float rli[16];
#pragma unroll
    for (int r = 0; r < 16; ++r) rli[r] = __builtin_amdgcn_rcpf(li_l[crow(r, hi)]);
    __syncthreads();
    ATT_LAS float* X = (ATT_LAS float*)lds + wq * 4096;
    if (cm == 1) {
#pragma unroll
        for (int d0 = 0; d0 < 4; ++d0)
#pragma unroll
            for (int r = 0; r < 16; ++r) X[(d0 * 16 + r) * 64 + lane] = lam * o[d0][r] * rli[r];
    }
    __syncthreads();
    if (cm == 0) {
        float ss[16];
#pragma unroll
        for (int r = 0; r < 16; ++r) { float s = 0.f;
#pragma unroll
            for (int d0 = 0; d0 < 4; ++d0) { const float v = o[d0][r] * rli[r] - X[(d0 * 16 + r) * 64 + lane]; o[d0][r] = v; s += v * v; }
            ss[r] = s; }
#pragma unroll
        for (int sh = 1; sh < 32; sh <<= 1)
#pragma unroll
            for (int r = 0; r < 16; ++r) ss[r] += __shfl_xor(ss[r], sh);
        float sw[4];
#pragma unroll
        for (int d0 = 0; d0 < 4; ++d0) sw[d0] = subw[d0 * 32 + r32] * 0.8f;
#pragma unroll
        for (int r = 0; r < 16; ++r) { const float rs = __builtin_amdgcn_rsqf(ss[r] * (1.f / 128.f) + 1e-5f);
            unsigned short* yp = YA + (size_t)(qlo + crow(r, hi)) * 1024 + h * 128 + r32;
#pragma unroll
            for (int d0 = 0; d0 < 4; ++d0) { const unsigned w = cvtpk(o[d0][r] * rs * sw[d0], 0.f); yp[d0 * 32] = (unsigned short)(w & 0xffffu); } }
    }
    __syncthreads();
#undef ROW
#undef VMW
#undef SLOAD_H
#undef SWRITE_H
#undef RESC
#undef KBASE
#undef MASKT
#undef HALF_STEP
}
#undef KSWZ
#undef SBAR
}

namespace ssm {
#define SSM_LAS __attribute__((address_space(3)))
typedef unsigned short bf16_t;
typedef short bf16x8 __attribute__((ext_vector_type(8)));
typedef float f32x16 __attribute__((ext_vector_type(16)));
typedef float f32x4 __attribute__((ext_vector_type(4)));
typedef float f32x2 __attribute__((ext_vector_type(2)));
typedef unsigned u32x2 __attribute__((ext_vector_type(2)));
constexpr int RUN = 256, NRUN = 32, XROW = 272;
constexpr int WAVE_LDS = 32 * XROW;
__device__ __forceinline__ unsigned cvtpk(float lo, float hi) { unsigned r; asm volatile("v_cvt_pk_bf16_f32 %0, %1, %2" : "=v"(r) : "v"(lo), "v"(hi)); return r; }
__device__ __forceinline__ float bf_lo(unsigned w) { return __builtin_bit_cast(float, w << 16); }
__device__ __forceinline__ float bf_hi(unsigned w) { return __builtin_bit_cast(float, w & 0xffff0000u); }
__device__ __forceinline__ float gelu_tanh(float x) {
    const float z2 = 2.f * 0.7978845608028654f * (x + 0.044715f * x * x * x);
    return x * __builtin_amdgcn_rcpf(1.f + __builtin_amdgcn_exp2f(-1.4426950408889634f * z2));
}
template <bool PASS2>
__device__ __forceinline__ void run_item(int g, int r, int lane, const bf16_t* Z  , const f32x2* abar, const bf16_t* BbarT, const bf16_t* CmatT,
                                         const float* dskip, f32x2* E, bf16_t* YP, SSM_LAS char* xl) {
    const int hi = lane >> 5, c32 = lane & 31;
    const f32x2 a = abar[g * 64 + lane]; const float ar = a.x, ai = a.y;
    const bf16x8 bre0 = *(const bf16x8*)(BbarT + ((size_t)((g * 2 + 0) * 64 + c32) * 16 + 8 * hi));
    const bf16x8 bre1 = *(const bf16x8*)(BbarT + ((size_t)((g * 2 + 0) * 64 + 32 + c32) * 16 + 8 * hi));
    const bf16x8 bim0 = *(const bf16x8*)(BbarT + ((size_t)((g * 2 + 1) * 64 + c32) * 16 + 8 * hi));
    const bf16x8 bim1 = *(const bf16x8*)(BbarT + ((size_t)((g * 2 + 1) * 64 + 32 + c32) * 16 + 8 * hi));
    float xr = 0.f, xi = 0.f;
    bf16x8 cop[4]; f32x4 d4 = (f32x4){0.f, 0.f, 0.f, 0.f};
    if (PASS2) {
        float pr = ar, pi = ai;
#pragma unroll
        for (int s = 0; s < 8; ++s) { const float nr = pr * pr - pi * pi, ni = 2.f * pr * pi; pr = nr; pi = ni; }
        for (int j = 0; j < r; ++j) { const f32x2 e = E[(size_t)(g * NRUN + j) * 64 + lane]; const float nr = pr * xr - pi * xi + e.x, ni = pr * xi + pi * xr + e.y; xr = nr; xi = ni; }
#pragma unroll
        for (int kk = 0; kk < 4; ++kk) cop[kk] = *(const bf16x8*)(CmatT + ((size_t)(g * 16 + (lane & 15)) * 128 + 32 * kk + 8 * (lane >> 4)));
        d4 = *(const f32x4*)(dskip + g * 16 + 4 * (lane >> 4));
    }
    for (int blk = 0; blk < RUN / 32; ++blk) {
        const int t0 = r * RUN + blk * 32;
        const bf16x8 ua = *(const bf16x8*)(Z + (size_t)(t0 + c32) * 8192 + g * 16 + 8 * hi);
        f32x16 Are = __builtin_amdgcn_mfma_f32_32x32x16_bf16(ua, bre0, f32x16{}, 0, 0, 0);
        f32x16 Bre = __builtin_amdgcn_mfma_f32_32x32x16_bf16(ua, bre1, f32x16{}, 0, 0, 0);
        f32x16 Aim = __builtin_amdgcn_mfma_f32_32x32x16_bf16(ua, bim0, f32x16{}, 0, 0, 0);
        f32x16 Bim = __builtin_amdgcn_mfma_f32_32x32x16_bf16(ua, bim1, f32x16{}, 0, 0, 0);
#pragma unroll
        for (int q = 0; q < 16; ++q) {
            auto s0 = __builtin_amdgcn_permlane32_swap(__float_as_uint(Are[q]), __float_as_uint(Bre[q]), false, false); Are[q] = __uint_as_float(s0[0]); Bre[q] = __uint_as_float(s0[1]);
            auto s1 = __builtin_amdgcn_permlane32_swap(__float_as_uint(Aim[q]), __float_as_uint(Bim[q]), false, false); Aim[q] = __uint_as_float(s1[0]); Bim[q] = __uint_as_float(s1[1]);
        }
#pragma unroll
        for (int q = 0; q < 4; ++q)
#pragma unroll
            for (int h2 = 0; h2 < 2; ++h2)
#pragma unroll
                for (int i = 0; i < 4; ++i) {
                    const int reg = 4 * q + i, tl = 8 * q + 4 * h2 + i;
                    const float bur = h2 ? Bre[reg] : Are[reg], bui = h2 ? Bim[reg] : Aim[reg];
                    const float nr = fmaf(ar, xr, fmaf(-ai, xi, bur)), ni = fmaf(ar, xi, fmaf(ai, xr, bui));
                    xr = nr; xi = ni;
                    if (PASS2) *(SSM_LAS unsigned*)(xl + tl * XROW + 4 * lane) = cvtpk(xr, xi);
                }
        if (PASS2) {
#pragma unroll
            for (int tb = 0; tb < 2; ++tb) {
                f32x4 acc = (f32x4){0.f, 0.f, 0.f, 0.f};
#pragma unroll
                for (int kk = 0; kk < 4; ++kk) { const bf16x8 bx = *(const SSM_LAS bf16x8*)(xl + (16 * tb + (lane & 15)) * XROW + 64 * kk + 16 * (lane >> 4));
                    acc = __builtin_amdgcn_mfma_f32_16x16x32_bf16(cop[kk], bx, acc, 0, 0, 0); }
                const int t = t0 + 16 * tb + (lane & 15), m0 = 4 * (lane >> 4);
                const u32x2 uw = *(const u32x2*)(Z + (size_t)t * 8192 + g * 16 + m0);
                const float y0 = gelu_tanh(acc[0] + d4[0] * bf_lo(uw.x)), y1 = gelu_tanh(acc[1] + d4[1] * bf_hi(uw.x));
                const float y2 = gelu_tanh(acc[2] + d4[2] * bf_lo(uw.y)), y3 = gelu_tanh(acc[3] + d4[3] * bf_hi(uw.y));
                u32x2 ow; ow.x = cvtpk(y0, y1); ow.y = cvtpk(y2, y3);
                *(u32x2*)(YP + (size_t)t * 1024 + g * 16 + m0) = ow;
            }
        }
    }
    if (!PASS2) E[(size_t)(g * NRUN + r) * 64 + lane] = (f32x2){xr, xi};
}
}

constexpr int NWAVES = 8;
constexpr int S_ = 8192, DM = 2048, INW = 8192;
constexpr int ZU = 0, ZQ = 1024, ZK = 2048, ZV = 3072, ZGS = 4096, ZGA = 6144;
constexpr int NEXP = 32, DFF = 512;
constexpr int XG_ROWS = 2 * S_ + NEXP * 256;
constexpr size_t MiB = 1u << 20;
constexpr size_t WS_CTL = 0, CTL_ZERO_BYTES = 1 * MiB;
constexpr size_t WS_ROPE = 2 * MiB;
constexpr size_t WS_SSMT = 4 * MiB;
constexpr size_t WS_ROUTE = 6 * MiB;
constexpr size_t WS_WIN = 8 * MiB;
constexpr size_t WS_WGLU = 40 * MiB;
constexpr size_t WS_WPS = 42 * MiB, WS_WPA = 46 * MiB;
constexpr size_t WS_WOUT = 50 * MiB;
constexpr size_t WS_WGU = 58 * MiB;
constexpr size_t WS_WD = 186 * MiB;
constexpr size_t WS_Z = 250 * MiB;
constexpr size_t WS_XG = WS_Z, WS_ACT = WS_Z + 96 * MiB;
constexpr size_t WS_XN = 378 * MiB;
constexpr size_t WS_YPRE = 410 * MiB, WS_YSSM = 426 * MiB;
constexpr size_t WS_Y = WS_XN;
constexpr size_t WS_YATT = 442 * MiB;
constexpr size_t WS_T1 = 458 * MiB, WS_MG = 490 * MiB;
constexpr size_t WS_END = 522 * MiB;
constexpr int CW_CNT = 64;
constexpr int CW_BAR = 4096;
constexpr int RING_OFF = 0, RING_BYTES = 131072;
constexpr int LDSCTL_OFF = RING_BYTES, MISC_OFF = LDSCTL_OFF + 320;
constexpr int LDS_BYTES = 147456;
#define GAS __attribute__((address_space(1)))
#define LAS __attribute__((address_space(3)))
typedef unsigned short bf16;
typedef unsigned v4u __attribute__((ext_vector_type(4)));
typedef float f32x4 __attribute__((ext_vector_type(4)));
typedef short bf16x8 __attribute__((ext_vector_type(8)));
typedef GAS unsigned gu32;
typedef GAS unsigned long long gu64;
#define RLX_AGENT __ATOMIC_RELAXED, __HIP_MEMORY_SCOPE_AGENT
#define LDS_WAIT() asm volatile("s_waitcnt lgkmcnt(0)" ::: "memory")
#define VM_WAIT() asm volatile("s_waitcnt vmcnt(0)" ::: "memory")
__device__ __forceinline__ unsigned long long rt() { return __builtin_amdgcn_s_memrealtime(); }
__device__ __forceinline__ unsigned f2bf(float f) { unsigned u = __builtin_bit_cast(unsigned, f); return (u + 0x7fffu + ((u >> 16) & 1u)) >> 16; }
__device__ __forceinline__ unsigned pk2(float lo, float hi) { return f2bf(lo) | (f2bf(hi) << 16); }

#define XB_TMO      128
#define XB_XCNT(j)  (256  + 64 * (j))
#define XB_XSUB(j)  (1280 + 64 * (j))
#define XB_XGEN(j)  (2304 + 64 * (j))
#define XB_TOP      3328
#define XB_TOPGEN   3392
#define XCD_BAR_WORDS 3456
#define XB_SPIN_CAP (1u << 18)

__device__ __forceinline__ unsigned xb_ld(unsigned* p)              { return __hip_atomic_load(p, __ATOMIC_RELAXED, __HIP_MEMORY_SCOPE_AGENT); }
__device__ __forceinline__ unsigned xb_add(unsigned* p, unsigned v) { return __hip_atomic_fetch_add(p, v, __ATOMIC_RELAXED, __HIP_MEMORY_SCOPE_AGENT); }
__device__ __forceinline__ unsigned xb_xcc_id() { return (unsigned)__builtin_amdgcn_s_getreg((3 << 11) | 20) & 0xFu; }
#define XB_SPIN(cond, bar) do { unsigned _sp = 0; while (cond) { __builtin_amdgcn_s_sleep(1); \
    if ((++_sp & 255u) == 0u) { if (xb_ld(&(bar)[XB_TMO])) break; if (_sp > XB_SPIN_CAP) { atomicAdd(&(bar)[XB_TMO], 1u); break; } } } } while (0)

struct XcdBarrier {
    unsigned* bar; unsigned x;
    volatile LAS unsigned* st;
};

__device__ __forceinline__ XcdBarrier xcd_barrier_post(unsigned* bar, volatile LAS unsigned* st) {
    XcdBarrier b; b.bar = bar; b.x = xb_xcc_id(); b.st = st;
    if (threadIdx.x == 0) (void)xb_add(&bar[XB_XCNT(b.x)], 1u);
    return b;
}
__device__ __forceinline__ void xcd_barrier_complete(unsigned* bar, unsigned x, unsigned& nloc, unsigned& nx) {
    const unsigned G = gridDim.x * gridDim.y * gridDim.z;
    unsigned sum, cnt, mine, sp = 0u;
    for (;;) {
        sum = 0u; cnt = 0u; mine = 0u;
#pragma unroll
        for (unsigned j = 0; j < 16; ++j) { const unsigned c = xb_ld(&bar[XB_XCNT(j)]); sum += c; cnt += (c > 0u) ? 1u : 0u; mine = (j == x) ? c : mine; }
        if (sum == G) break;
        __builtin_amdgcn_s_sleep(1);
        if ((++sp & 255u) == 0u) { if (xb_ld(&bar[XB_TMO])) break; if (sp > XB_SPIN_CAP) { atomicAdd(&bar[XB_TMO], 1u); break; } }
    }
    nloc = mine > 0u ? mine : 1u; nx = cnt > 0u ? cnt : 1u;
}

__device__ __forceinline__ void xcd_barrier(const XcdBarrier& b) {
    asm volatile("s_waitcnt vmcnt(0)" ::: "memory");
    __syncthreads();
    if (threadIdx.x == 0) {
        unsigned* bar = b.bar;
        __builtin_amdgcn_s_waitcnt(0);
        unsigned nloc = b.st[0], nx = b.st[1];
        if (nloc == 0u) { xcd_barrier_complete(bar, b.x, nloc, nx); b.st[0] = nloc; b.st[1] = nx; }
        const unsigned old = xb_add(&bar[XB_XSUB(b.x)], 1u);
        const unsigned gen = old / nloc;
        if (old + 1u == (gen + 1u) * nloc) {
            __builtin_amdgcn_fence(__ATOMIC_RELEASE, "agent");
            asm volatile("s_waitcnt vmcnt(0)" ::: "memory");
            const unsigned og = xb_add(&bar[XB_TOP], 1u);
            const unsigned tg = og / nx;
            if (og + 1u == (tg + 1u) * nx) xb_add(&bar[XB_TOPGEN], 1u);
            else XB_SPIN(xb_ld(&bar[XB_TOPGEN]) == tg, bar);
            __builtin_amdgcn_fence(__ATOMIC_ACQUIRE, "agent");
            xb_add(&bar[XB_XGEN(b.x)], 1u);
            asm volatile("s_waitcnt vmcnt(0)" ::: "memory");
        } else {
            XB_SPIN(xb_ld(&bar[XB_XGEN(b.x)]) == gen, bar);
            __builtin_amdgcn_fence(__ATOMIC_ACQUIRE, "agent");
            asm volatile("s_waitcnt vmcnt(0)" ::: "memory");
        }
    }
    __syncthreads();
}

struct Args {
    const float* in[29]; const int* pos; float* out; unsigned char* ws; int ph_lo, ph_hi;
};
struct Frame {
    LAS unsigned char* lds; volatile LAS unsigned* MISC; gu32* ctl;
    int tid, lane, wave, vcu, G;
};
__device__ __forceinline__ float wave_sum(float v) {
#pragma unroll
    for (int o = 1; o < 64; o <<= 1) v += __shfl_xor(v, o);
    return v;
}
__device__ __forceinline__ void sincos_acc(double ang, float& s, float& c) {
    const double k = __builtin_rint(ang * 0.63661977236758134308), y = __builtin_fma(-k, 1.57079632679489661923, ang) - k * 6.123233995736766e-17, y2 = y * y;
    const double sp = y * (1.0 + y2 * (-1.0 / 6 + y2 * (1.0 / 120 + y2 * (-1.0 / 5040 + y2 * (1.0 / 362880 + y2 * (-1.0 / 39916800))))));
    const double cp = 1.0 + y2 * (-0.5 + y2 * (1.0 / 24 + y2 * (-1.0 / 720 + y2 * (1.0 / 40320 + y2 * (-1.0 / 3628800 + y2 * (1.0 / 479001600))))));
    const int q = (int)((long long)k & 3);
    const double ss = (q == 0) ? sp : (q == 1) ? cp : (q == 2) ? -sp : -cp;
    const double cc = (q == 0) ? cp : (q == 1) ? -sp : (q == 2) ? -cp : sp;
    s = (float)ss; c = (float)cc;
}
template <int MODE>
__device__ __forceinline__ void p0_transpose_item(const float* W, int K, int N, bf16* WT, int row_off, LAS float* scr, int kb, int nb, int lane) {
    const int k0 = 64 * kb, n0 = 32 * nb;
#pragma unroll 8
    for (int i = 0; i < 32; ++i) { const int kk = 2 * i + (lane >> 5); scr[kk * 33 + (lane & 31)] = W[(size_t)(k0 + kk) * N + n0 + (lane & 31)]; }
    LDS_WAIT(); asm volatile("" ::: "memory");
    const int c = lane & 7;
#pragma unroll
    for (int j = 0; j < 4; ++j) { const int n = (lane >> 3) + 8 * j; const LAS float* s = scr + (8 * c) * 33 + n;
        v4u o; o.x = pk2(s[0 * 33], s[1 * 33]); o.y = pk2(s[2 * 33], s[3 * 33]); o.z = pk2(s[4 * 33], s[5 * 33]); o.w = pk2(s[6 * 33], s[7 * 33]);
        int row = row_off + n0 + n;
        if (MODE == 1) { const int nn = n0 + n; if (nn >= ZQ && nn < ZV) { const int d = nn & 63, dd = d & 31; row = (nn & ~63) + 8 * (dd >> 2) + (dd & 3) + ((d >= 32) ? 4 : 0); } }
        *(GAS v4u*)(WT + (size_t)row * K + k0 + 8 * c) = o; }
    LDS_WAIT(); asm volatile("" ::: "memory");
}

__global__ void __launch_bounds__(NWAVES * 64, 2) mega_fwd(Args args) {
    extern __shared__ __attribute__((aligned(16))) unsigned char lds[];
    Frame F;
    F.lds = (LAS unsigned char*)lds;
    F.MISC = (volatile LAS unsigned*)(F.lds + MISC_OFF);
    F.tid = threadIdx.x; F.lane = F.tid & 63; F.wave = __builtin_amdgcn_readfirstlane(F.tid >> 6);
    F.G = gridDim.x; { const int bx = blockIdx.x; F.vcu = (F.G % 8 == 0) ? (bx % 8) * (F.G / 8) + bx / 8 : bx; }
    unsigned char* ws = args.ws;
    F.ctl = (gu32*)(ws + WS_CTL);
    for (int u = F.tid; u < (LDS_BYTES - LDSCTL_OFF) / 4; u += NWAVES * 64) ((LAS unsigned*)(F.lds + LDSCTL_OFF))[u] = 0u;
    __syncthreads();
    const int lo = args.ph_lo, hi = args.ph_hi; const bool multi = (hi - lo) > 1;
    XcdBarrier bar; bar.bar = (unsigned*)(F.ctl + CW_BAR); bar.x = 0; bar.st = nullptr;
    if (multi) bar = xcd_barrier_post((unsigned*)(F.ctl + CW_BAR), F.MISC + 8);
#ifndef PHASE_MASK
#define PHASE_MASK 0xfff
#endif
#define IN(k) (((PHASE_MASK >> (k)) & 1) && lo <= (k) && (k) < hi)
#define GRID_BAR() do { if (multi) xcd_barrier(bar); } while (0)
    const int gw = F.vcu * NWAVES + F.wave, NGW = F.G * NWAVES;
    float* ROPE = (float*)(ws + WS_ROPE);
    ssm::f32x2* ABAR = (ssm::f32x2*)(ws + WS_SSMT); bf16* BBART = (bf16*)(ws + WS_SSMT + 32768); bf16* CMATT = (bf16*)(ws + WS_SSMT + 32768 + 262144);
    ssm::f32x2* ESTATE = (ssm::f32x2*)(ws + WS_SSMT + 1 * MiB);
    int* R_EID = (int*)(ws + WS_ROUTE); int* R_POS = R_EID + 2 * S_; float* R_GATE = (float*)(R_POS + 2 * S_);
    int* SLOT_OF = (int*)(R_GATE + 2 * S_); float* SLOT_W = (float*)(SLOT_OF + XG_ROWS);
    bf16* WIN = (bf16*)(ws + WS_WIN); bf16* WGLU = (bf16*)(ws + WS_WGLU); bf16* WPS = (bf16*)(ws + WS_WPS); bf16* WPA = (bf16*)(ws + WS_WPA); bf16* WOUT = (bf16*)(ws + WS_WOUT);
    bf16* WGU = (bf16*)(ws + WS_WGU); bf16* WD = (bf16*)(ws + WS_WD);
    bf16* Z = (bf16*)(ws + WS_Z); bf16* XG = (bf16*)(ws + WS_XG); bf16* ACT = (bf16*)(ws + WS_ACT);
    bf16* XN = (bf16*)(ws + WS_XN); bf16* H2 = XN; bf16* YB = (bf16*)(ws + WS_Y);
    bf16* YPRE = (bf16*)(ws + WS_YPRE); bf16* YSSM = (bf16*)(ws + WS_YSSM); bf16* YATT = (bf16*)(ws + WS_YATT);
    bf16* T1 = (bf16*)(ws + WS_T1); bf16* MG = (bf16*)(ws + WS_MG);
    const float* x = args.in[0];

    if (IN(0)) {
        LAS float* scr = (LAS float*)(F.lds + RING_OFF + F.wave * 16384);
        constexpr int I0 = 8192, I1 = I0 + 512, I2 = I1 + 1024, I3 = I2 + 1024, I4 = I3 + 2048, I5 = I4 + 16384, I6 = I5 + 16384, I7 = I6 + 16384;
        for (int it = gw; it < I7; it += NGW) {
            if (it < I0) { p0_transpose_item<1>(args.in[3], DM, INW, WIN, 0, scr, it / 256, it % 256, F.lane); }
            else if (it < I1) { const int r = it - I0; p0_transpose_item<0>(args.in[12], 1024, 1024, WGLU, 0, scr, r / 32, r % 32, F.lane); }
            else if (it < I2) { const int r = it - I1; p0_transpose_item<0>(args.in[19], 1024, DM, WPS, 0, scr, r / 64, r % 64, F.lane); }
            else if (it < I3) { const int r = it - I2; p0_transpose_item<0>(args.in[20], 1024, DM, WPA, 0, scr, r / 64, r % 64, F.lane); }
            else if (it < I4) { const int r = it - I3; p0_transpose_item<0>(args.in[21], DM, DM, WOUT, 0, scr, r / 64, r % 64, F.lane); }
            else if (it < I6) { const int up = it >= I5, r = it - (up ? I5 : I4), e = r >> 9, q = r & 511, kb = q >> 4, nb = q & 15;
                const int n0 = 32 * nb, roff = 256 * (n0 >> 7) + 128 * up + (n0 & 127) - n0;
                p0_transpose_item<0>(args.in[up ? 26 : 25] + (size_t)e * DM * DFF, DM, DFF, WGU + (size_t)e * 1024 * DM, roff, scr, kb, nb, F.lane); }
            else { const int r = it - I6, e = r >> 9, q = r & 511, kb = q >> 6, nb = q & 63;
                p0_transpose_item<0>(args.in[27] + (size_t)e * DFF * DM, DFF, DM, WD + (size_t)e * DM * DFF, 0, scr, kb, nb, F.lane); }
        }
        { const float* w1 = args.in[2];
          for (int m = gw; m < S_; m += NGW) {
            const GAS f32x4* xr = (const GAS f32x4*)(x + (size_t)m * DM) + F.lane; f32x4 v[8]; float s = 0.f;
#pragma unroll
            for (int j = 0; j < 8; ++j) { v[j] = xr[64 * j]; s += (v[j].x * v[j].x + v[j].y * v[j].y) + (v[j].z * v[j].z + v[j].w * v[j].w); }
            const float rstd = __builtin_amdgcn_rsqf(wave_sum(s) * (1.f / DM) + 1e-6f);
            GAS unsigned long long* o8 = (GAS unsigned long long*)(XN + (size_t)m * DM) + F.lane;
#pragma unroll
            for (int j = 0; j < 8; ++j) { const f32x4 w = *((const f32x4*)w1 + F.lane + 64 * j);
                o8[64 * j] = (unsigned long long)pk2(v[j].x * rstd * w.x, v[j].y * rstd * w.y) | ((unsigned long long)pk2(v[j].z * rstd * w.z, v[j].w * rstd * w.w) << 32); }
          } }
        { const int gt = F.vcu * (NWAVES * 64) + F.tid, NGT = F.G * NWAVES * 64;
          for (int e = gt; e < S_ * 32; e += NGT) { const int row = e >> 5, i = e & 31;
            const float inv_freq = 1.0f / __builtin_powf(10000.0f, (float)(2 * i) * (1.0f / 64.0f));
            const float ang = (float)args.pos[row] * inv_freq; float s, c; sincos_acc((double)ang, s, c);
            ROPE[(size_t)row * 64 + i] = c; ROPE[(size_t)row * 64 + 32 + i] = s; }
          for (int e = gt; e < 64 * 64; e += NGT) { const int g = e >> 6, p = e & 63;
            const float lr = args.in[4][e], li = args.in[5][e]; const float dt = __builtin_expf(args.in[6][g]);
            const float mag = __builtin_expf(lr * dt); float sn, cs; sincos_acc((double)(li * dt), sn, cs);
            const float ar = mag * cs, ai = mag * sn, nr = ar - 1.f, ni = ai, den = lr * lr + li * li;
            const float fr = (nr * lr + ni * li) / den, fi = (ni * lr - nr * li) / den;
            ABAR[e] = (ssm::f32x2){ar, ai};
            const float* br = args.in[7] + (size_t)e * 16; const float* bi = args.in[8] + (size_t)e * 16;
#pragma unroll
            for (int m = 0; m < 16; m += 2) {
                const float r0 = fr * br[m] - fi * bi[m], i0 = fr * bi[m] + fi * br[m], r1 = fr * br[m + 1] - fi * bi[m + 1], i1 = fr * bi[m + 1] + fi * br[m + 1];
                *(unsigned*)(BBART + ((size_t)((g * 2 + 0) * 64 + p) * 16 + m)) = pk2(r0, r1);
                *(unsigned*)(BBART + ((size_t)((g * 2 + 1) * 64 + p) * 16 + m)) = pk2(i0, i1); }
#pragma unroll
            for (int m = 0; m < 16; ++m) *(unsigned*)(CMATT + ((size_t)(g * 16 + m) * 128 + 2 * p)) = pk2(args.in[9][(size_t)(g * 16 + m) * 64 + p], -args.in[10][(size_t)(g * 16 + m) * 64 + p]);
          } }
        GRID_BAR();
    }
    if (IN(1)) {
        pg8::Gemm g{XN, WIN, S_, INW, DM}; pg8::StaticOrder S; S.init(S_, INW, F.G, (int)blockIdx.x);
        pg8::EpiInProj E{Z, ROPE};
        pg8::gemm_phase<pg8::EpiInProj, pg8::StaticOrder, true, true>(F.lds + RING_OFF, g, S, E);
        GRID_BAR();
    }
    if (IN(2)) {
        for (int it = gw; it < 64 * ssm::NRUN; it += NGW)
            ssm::run_item<false>(it >> 5, it & 31, F.lane, Z, ABAR, BBART, CMATT, args.in[11], ESTATE, YPRE, (LAS char*)(F.lds + F.wave * ssm::WAVE_LDS));
        GRID_BAR();
    }
    if (IN(3)) {
        for (int it = gw; it < 64 * ssm::NRUN; it += NGW)
            ssm::run_item<true>(it >> 5, it & 31, F.lane, Z, ABAR, BBART, CMATT, args.in[11], ESTATE, YPRE, (LAS char*)(F.lds + F.wave * ssm::WAVE_LDS));
        __syncthreads();
        const float s1 = wave_sum(args.in[14][F.lane] * args.in[15][F.lane]), s2 = wave_sum(args.in[16][F.lane] * args.in[17][F.lane]);
        const float lam = __builtin_expf(s1) - __builtin_expf(s2) + 0.2f;
        for (int u = F.vcu; u < 256; u += F.G) { const int h = u >> 5, s = u & 31;
            att::attn_block(h, s, Z, ZQ, ZK, ZV, lam, args.in[18], YATT, (LAS char*)F.lds);
            att::attn_block(h, 63 - s, Z, ZQ, ZK, ZV, lam, args.in[18], YATT, (LAS char*)F.lds); }
        GRID_BAR();
    }
    if (IN(4)) {
        pg8::Gemm g{YPRE, WGLU, S_, 1024, 1024}; pg8::StaticOrder S; S.init(S_, 1024, F.G, (int)blockIdx.x);
        pg8::EpiGlu E{YPRE, args.in[13], YSSM};
        pg8::gemm_phase<pg8::EpiGlu, pg8::StaticOrder, true, true>(F.lds + RING_OFF, g, S, E);
        GRID_BAR();
    }
    if (IN(5)) {
        { pg8::Gemm g{YSSM, WPS, S_, DM, 1024}; pg8::StaticOrder S; S.init(S_, DM, F.G, (int)blockIdx.x);
          pg8::EpiProj<true> E{Z, ZGS, T1, MG};
          pg8::gemm_phase<pg8::EpiProj<true>, pg8::StaticOrder, true, true>(F.lds + RING_OFF, g, S, E); }
        VM_WAIT(); __syncthreads();
        { pg8::Gemm g{YATT, WPA, S_, DM, 1024}; pg8::StaticOrder S; S.init(S_, DM, F.G, (int)blockIdx.x);
          pg8::EpiProj<false> E{Z, ZGA, T1, MG};
          pg8::gemm_phase<pg8::EpiProj<false>, pg8::StaticOrder, true, true>(F.lds + RING_OFF, g, S, E); }
        GRID_BAR();
    }
    if (IN(6)) {
        pg8::Gemm g{MG, WOUT, S_, DM, DM}; pg8::StaticOrder S; S.init(S_, DM, F.G, (int)blockIdx.x);
        pg8::EpiOut E{x, args.out};
        pg8::gemm_phase<pg8::EpiOut, pg8::StaticOrder, true, true>(F.lds + RING_OFF, g, S, E);
        GRID_BAR();
    }
    if (IN(7)) {
        const float* w2 = args.in[22]; const float* rg = args.in[23]; const float* re = args.in[24];
        int ln = F.lane; asm volatile("" : "+v"(ln));
        for (int m = gw; m < S_; m += NGW) {
            const GAS f32x4* xr = (const GAS f32x4*)(args.out + (size_t)m * DM) + ln; f32x4 v[8]; float s = 0.f;
#pragma unroll
            for (int j = 0; j < 8; ++j) { v[j] = xr[64 * j]; s += (v[j].x * v[j].x + v[j].y * v[j].y) + (v[j].z * v[j].z + v[j].w * v[j].w); }
            const float rstd = __builtin_amdgcn_rsqf(wave_sum(s) * (1.f / DM) + 1e-6f);
            GAS unsigned long long* o8 = (GAS unsigned long long*)(H2 + (size_t)m * DM) + ln;
#pragma unroll
            for (int j = 0; j < 8; ++j) { const f32x4 w = *((const f32x4*)w2 + ln + 64 * j); v[j] = v[j] * rstd * w;
                o8[64 * j] = (unsigned long long)pk2(v[j].x, v[j].y) | ((unsigned long long)pk2(v[j].z, v[j].w) << 32); }
            float gl[4] = {0.f, 0.f, 0.f, 0.f};
#pragma unroll
            for (int j = 0; j < 8; ++j)
#pragma unroll
                for (int e = 0; e < 4; ++e) { const f32x4 w = *(const f32x4*)(rg + (size_t)(4 * (ln + 64 * j) + e) * 4);
                    gl[0] = fmaf(v[j][e], w.x, gl[0]); gl[1] = fmaf(v[j][e], w.y, gl[1]); gl[2] = fmaf(v[j][e], w.z, gl[2]); gl[3] = fmaf(v[j][e], w.w, gl[3]); }
#pragma unroll
            for (int g = 0; g < 4; ++g) gl[g] = wave_sum(gl[g]);
            int gi = 0; float gm = gl[0];
#pragma unroll
            for (int g = 1; g < 4; ++g) if (gl[g] > gm) { gm = gl[g]; gi = g; }
            float gs = 0.f;
#pragma unroll
            for (int g = 0; g < 4; ++g) gs += __builtin_expf(gl[g] - gm);
            const float gval = 1.f / gs;
            float el[8] = {0.f, 0.f, 0.f, 0.f, 0.f, 0.f, 0.f, 0.f};
#pragma unroll
            for (int j = 0; j < 8; ++j)
#pragma unroll
                for (int e = 0; e < 4; ++e) { const float* wp = re + (size_t)(4 * (ln + 64 * j) + e) * 32 + gi * 8; const f32x4 wa = *(const f32x4*)wp, wb = *(const f32x4*)(wp + 4);
                    el[0] = fmaf(v[j][e], wa.x, el[0]); el[1] = fmaf(v[j][e], wa.y, el[1]); el[2] = fmaf(v[j][e], wa.z, el[2]); el[3] = fmaf(v[j][e], wa.w, el[3]);
                    el[4] = fmaf(v[j][e], wb.x, el[4]); el[5] = fmaf(v[j][e], wb.y, el[5]); el[6] = fmaf(v[j][e], wb.z, el[6]); el[7] = fmaf(v[j][e], wb.w, el[7]); }
#pragma unroll
            for (int e = 0; e < 8; ++e) el[e] = wave_sum(el[e]);
            int i0 = 0; float v0 = el[0];
#pragma unroll
            for (int e = 1; e < 8; ++e) if (el[e] > v0) { v0 = el[e]; i0 = e; }
            int i1 = 0; float v1 = -__builtin_inff();
#pragma unroll
            for (int e = 0; e < 8; ++e) if (e != i0 && el[e] > v1) { v1 = el[e]; i1 = e; }
            const float e1 = __builtin_expf(v1 - v0), den = 1.f + e1;
            if (ln == 0) { const int ea = gi * 8 + i0, eb = gi * 8 + i1;
                R_EID[2 * m] = ea; R_EID[2 * m + 1] = eb; R_GATE[2 * m] = gval / den; R_GATE[2 * m + 1] = gval * e1 / den;
                R_POS[2 * m] = (int)__hip_atomic_fetch_add(F.ctl + CW_CNT + ea, 1u, RLX_AGENT); R_POS[2 * m + 1] = (int)__hip_atomic_fetch_add(F.ctl + CW_CNT + eb, 1u, RLX_AGENT); }
        }
        GRID_BAR();
    }
    LAS int* RT = (LAS int*)(F.lds + LDSCTL_OFF);
    if (hi > 8 && lo <= 10) {
        if (F.tid == 0) { int acc = 0; for (int e = 0; e < 32; ++e) { RT[e] = acc; acc += ((int)__hip_atomic_load(F.ctl + CW_CNT + e, RLX_AGENT) + 255) >> 8; } RT[32] = acc; }
        __syncthreads();
    }
    if (IN(8)) {
        for (int m = gw; m < S_; m += NGW) {
#pragma unroll
            for (int k = 0; k < 2; ++k) { const int e = R_EID[2 * m + k], dst = RT[e] * 256 + R_POS[2 * m + k];
                const GAS v4u* src = (const GAS v4u*)(H2 + (size_t)m * DM) + F.lane; GAS v4u* dp = (GAS v4u*)(XG + (size_t)dst * DM) + F.lane;
#pragma unroll
                for (int j = 0; j < 4; ++j) dp[64 * j] = src[64 * j];
                if (F.lane == 0) { SLOT_OF[dst] = 2 * m + k; SLOT_W[dst] = R_GATE[2 * m + k]; } }
        }
        for (int e = gw; e < 32; e += NGW) { const int cnt = (int)__hip_atomic_load(F.ctl + CW_CNT + e, RLX_AGENT), b = RT[e] * 256 + cnt, en = RT[e + 1] * 256;
            for (int r = b + F.lane; r < en; r += 64) { SLOT_OF[r] = -1; SLOT_W[r] = 0.f; } }
        GRID_BAR();
    }
    if (IN(9)) {
        pg8::Gemm g{XG, WGU, 0, 0, DM}; pg8::MoeOrder S{RT, 4, F.G, (int)blockIdx.x};
        pg8::EpiMoeUp E{ACT};
        pg8::gemm_phase<pg8::EpiMoeUp, pg8::MoeOrder, true, true>(F.lds + RING_OFF, g, S, E);
        GRID_BAR();
    }
    if (IN(10)) {
        pg8::Gemm g{ACT, WD, 0, 0, DFF}; pg8::MoeOrder S{RT, 8, F.G, (int)blockIdx.x};
        pg8::EpiMoeDown E{SLOT_OF, SLOT_W, YB};
        pg8::gemm_phase<pg8::EpiMoeDown, pg8::MoeOrder, true, true>(F.lds + RING_OFF, g, S, E);
        GRID_BAR();
    }
    if (IN(11)) {
        const float* fw = args.in[28];
        int ln = F.lane; asm volatile("" : "+v"(ln));
        for (int m = gw; m < S_; m += NGW) {
            GAS f32x4* xr = (GAS f32x4*)(args.out + (size_t)m * DM) + ln; f32x4 v[8]; float s = 0.f;
            const GAS unsigned long long* ya = (const GAS unsigned long long*)(YB + (size_t)(2 * m) * DM) + ln; const GAS unsigned long long* yb = ya + DM / 4;
#pragma unroll
            for (int j = 0; j < 8; ++j) { v[j] = xr[64 * j]; const unsigned long long a = ya[64 * j], b = yb[64 * j];
                const unsigned a0 = (unsigned)a, a1 = (unsigned)(a >> 32), b0 = (unsigned)b, b1 = (unsigned)(b >> 32);
                v[j].x += pg8::bf_lo(a0) + pg8::bf_lo(b0); v[j].y += pg8::bf_hi(a0) + pg8::bf_hi(b0); v[j].z += pg8::bf_lo(a1) + pg8::bf_lo(b1); v[j].w += pg8::bf_hi(a1) + pg8::bf_hi(b1);
                s += (v[j].x * v[j].x + v[j].y * v[j].y) + (v[j].z * v[j].z + v[j].w * v[j].w); }
            const float rstd = __builtin_amdgcn_rsqf(wave_sum(s) * (1.f / DM) + 1e-6f);
#pragma unroll
            for (int j = 0; j < 8; ++j) { const f32x4 w = *((const f32x4*)fw + ln + 64 * j); xr[64 * j] = v[j] * rstd * w; }
        }
    }
#undef IN
#undef GRID_BAR
}

extern "C" void kernel_launch(void* const* d_in, const int* in_sizes, int n_in, void* d_out, int out_size, void* d_ws, size_t ws_size, hipStream_t stream) {
    static int grid = 0;
    if (grid == 0) {
        if (n_in != 29 || out_size != S_ * DM || ws_size < WS_END) { fprintf(stderr, "kernel_launch: unexpected shapes (n_in %d out %d ws %zu)\n", n_in, out_size, ws_size); grid = -1; return; }
        int dev = 0, cus = 0;
        if (hipGetDevice(&dev) != hipSuccess || hipDeviceGetAttribute(&cus, hipDeviceAttributeMultiprocessorCount, dev) != hipSuccess) { grid = -1; return; }
        if (hipFuncSetAttribute((const void*)mega_fwd, hipFuncAttributeMaxDynamicSharedMemorySize, LDS_BYTES) != hipSuccess) { fprintf(stderr, "kernel_launch: hipFuncSetAttribute failed\n"); grid = -1; return; }
        grid = cus;
    }
    if (grid < 0) return;
    (void)in_sizes;
    if (hipMemsetAsync((char*)d_ws + WS_CTL, 0, CTL_ZERO_BYTES, stream) != hipSuccess) return;
    Args a{};
    for (int i = 0; i < 29; ++i) a.in[i] = (const float*)d_in[i];
    a.pos = (const int*)d_in[1]; a.out = (float*)d_out; a.ws = (unsigned char*)d_ws;
#ifndef MK_SPLIT
    a.ph_lo = 0; a.ph_hi = 12;
    hipLaunchKernelGGL(mega_fwd, dim3(grid), dim3(NWAVES * 64), LDS_BYTES, stream, a);
#else
    for (int p = 0; p < 12; ++p) { a.ph_lo = p; a.ph_hi = p + 1; hipLaunchKernelGGL(mega_fwd, dim3(grid), dim3(NWAVES * 64), LDS_BYTES, stream, a); }
#endif
}
```

```cpp
#include <hip/hip_runtime.h>
#include <cstdio>
#include <cstdint>
namespace pg8 {
#define PG8_LAS __attribute__((address_space(3)))
typedef unsigned short bf16_t;
typedef short bf16x8 __attribute__((ext_vector_type(8)));
typedef float f32x4 __attribute__((ext_vector_type(4)));
typedef unsigned u32x4 __attribute__((ext_vector_type(4)));
constexpr int BM = 256, BK = 64, HALF = 128, HTB = HALF * BK * 2  , STAGE_BYTES = 8 * HTB, NXCD = 8, WGM = 8;

__host__ __device__ __forceinline__ int lds_byte(int r, int c) { const int st = (r >> 4) * 2 + (c >> 5), rr = r & 15, cc = c & 31, ob = rr * 64 + cc * 2; return st * 1024 + (ob ^ (((ob >> 9) & 1) << 5)); }
__host__ __device__ __forceinline__ void stage_rc(int b, int& R, int& C) { const int st = b / 1024, sb = b % 1024, swz = sb ^ (((sb >> 9) & 1) << 5); R = (st >> 1) * 16 + swz / 64; C = (st & 1) * 32 + (swz % 64) / 2; }
__host__ __device__ __forceinline__ int perm32(int rho) { const int n = rho >> 4, i = rho & 15; return 8 * (i >> 2) + 4 * n + (i & 3); }

struct Unit { int pm, pn; };
struct Gemm { const bf16_t* A; const bf16_t* Bt; int M, N, K; };

struct StaticOrder {
    int nM, nN, nwg, G, c;
    __host__ __device__ void init(int M, int N, int G_, int c_) { nM = M / BM; nN = N / BM; nwg = nM * nN; G = G_; c = c_; }
    __host__ __device__ bool next(int i, Unit& u) const {
        const long L = (long)i * G + c; if (L >= nwg) return false;
        int wgid = (int)L; { const int q = nwg / NXCD, r = nwg % NXCD, xcd = wgid % NXCD, off = wgid / NXCD; wgid = (xcd < r ? xcd * (q + 1) : r * (q + 1) + (xcd - r) * q) + off; }
        const int nig = WGM * nN, gid = wgid / nig, fm = gid * WGM, gsz = (nM - fm) < WGM ? (nM - fm) : WGM;
        u.pm = fm + ((wgid % nig) % gsz); u.pn = (wgid % nig) / gsz; return true;
    }
    __device__ __forceinline__ void a_ready(const Unit&) const {}
    __device__ __forceinline__ void done(const Unit&) const {}
};

__device__ __forceinline__ unsigned cvt_pk_bf16(float lo, float hi) { unsigned r; asm volatile("v_cvt_pk_bf16_f32 %0, %1, %2" : "=v"(r) : "v"(lo), "v"(hi)); return r; }
typedef float f32x2 __attribute__((ext_vector_type(2)));
typedef unsigned u32x2 __attribute__((ext_vector_type(2)));
__device__ __forceinline__ float fsig(float x) { return __builtin_amdgcn_rcpf(1.f + __builtin_amdgcn_exp2f(-1.4426950408889634f * x)); }
__device__ __forceinline__ float bf_lo(unsigned w) { return __builtin_bit_cast(float, w << 16); }
__device__ __forceinline__ float bf_hi(unsigned w) { return __builtin_bit_cast(float, w & 0xffff0000u); }
__device__ __forceinline__ void unpack8(const u32x4 w, f32x4& a, f32x4& b) { a = (f32x4){bf_lo(w.x), bf_hi(w.x), bf_lo(w.y), bf_hi(w.y)}; b = (f32x4){bf_lo(w.z), bf_hi(w.z), bf_lo(w.w), bf_hi(w.w)}; }
__device__ __forceinline__ u32x4 pack8(const f32x4 a, const f32x4 b) { u32x4 w; w.x = cvt_pk_bf16(a[0], a[1]); w.y = cvt_pk_bf16(a[2], a[3]); w.z = cvt_pk_bf16(b[0], b[1]); w.w = cvt_pk_bf16(b[2], b[3]); return w; }
#define EPI_ROWS(...) _Pragma("unroll") for (int ai = 0; ai < 2; ++ai) _Pragma("unroll") for (int m = 0; m < 4; ++m) { const int row = row0 + ai * HALF + m * 16; __VA_ARGS__ }

struct EpiInProj {
    static constexpr bool PERM = true, AFTER_DRAIN = false;
    bf16_t* Z; const float* rope;
    __device__ __forceinline__ void operator()(const f32x4 (&acc)[2][2][4][2], const Unit& u, int wr, int wc, int fr, int fq) const {
        const int row0 = u.pm * BM + wr * 64 + fr, col0 = u.pn * BM + wc * 32 + 8 * fq, kind = u.pn >> 2;
        const int i4 = ((wc & 1) * 4 + fq) * 4;
        EPI_ROWS(
            bf16_t* rowp = Z + (size_t)row * 8192 + col0;
            f32x4 cs = (f32x4){1.f, 1.f, 1.f, 1.f}, sn = (f32x4){0.f, 0.f, 0.f, 0.f};
            if (kind == 1 || kind == 2) { cs = *(const f32x4*)(rope + (size_t)row * 64 + i4); sn = *(const f32x4*)(rope + (size_t)row * 64 + 32 + i4); }
            _Pragma("unroll") for (int bj = 0; bj < 2; ++bj) {
                f32x4 v0 = acc[ai][bj][m][0], v1 = acc[ai][bj][m][1];
                if (kind == 1 || kind == 2) { const f32x4 lo = v0 * cs - v1 * sn, hi = v1 * cs + v0 * sn; v0 = lo; v1 = hi; }
                else if (kind >= 4) { _Pragma("unroll") for (int e = 0; e < 4; ++e) { v0[e] = fsig(v0[e]); v1[e] = fsig(v1[e]); } }
                *(u32x4*)(rowp + bj * HALF) = pack8(v0, v1); }
        )
    }
};
struct EpiGlu {
    static constexpr bool PERM = true, AFTER_DRAIN = false;
    const bf16_t* Yp; const float* bias; bf16_t* O;
    __device__ __forceinline__ void operator()(const f32x4 (&acc)[2][2][4][2], const Unit& u, int wr, int wc, int fr, int fq) const {
        const int row0 = u.pm * BM + wr * 64 + fr, col0 = u.pn * BM + wc * 32 + 8 * fq;
        EPI_ROWS(
            _Pragma("unroll") for (int bj = 0; bj < 2; ++bj) { const size_t off = (size_t)row * 1024 + col0 + bj * HALF;
                f32x4 y0, y1; unpack8(*(const u32x4*)(Yp + off), y0, y1);
                const f32x4 b0 = *(const f32x4*)(bias + col0 + bj * HALF), b1 = *(const f32x4*)(bias + col0 + bj * HALF + 4);
                f32x4 v0 = acc[ai][bj][m][0] + b0, v1 = acc[ai][bj][m][1] + b1;
                _Pragma("unroll") for (int e = 0; e < 4; ++e) { v0[e] = y0[e] * fsig(v0[e]); v1[e] = y1[e] * fsig(v1[e]); }
                *(u32x4*)(O + off) = pack8(v0, v1); }
        )
    }
};
template <bool FIRST> struct EpiProj {
    static constexpr bool PERM = true, AFTER_DRAIN = false;
    const bf16_t* Z; int gcol; bf16_t* T1; bf16_t* MG;
    __device__ __forceinline__ void operator()(const f32x4 (&acc)[2][2][4][2], const Unit& u, int wr, int wc, int fr, int fq) const {
        const int row0 = u.pm * BM + wr * 64 + fr, col0 = u.pn * BM + wc * 32 + 8 * fq;
        EPI_ROWS(
            _Pragma("unroll") for (int bj = 0; bj < 2; ++bj) { const size_t off = (size_t)row * 2048 + col0 + bj * HALF;
                f32x4 g0, g1; unpack8(*(const u32x4*)(Z + (size_t)row * 8192 + gcol + col0 + bj * HALF), g0, g1);
                f32x4 v0 = acc[ai][bj][m][0] * g0, v1 = acc[ai][bj][m][1] * g1;
                if (FIRST) { *(u32x4*)(T1 + off) = pack8(v0, v1); }
                else { f32x4 t0, t1; unpack8(*(const u32x4*)(T1 + off), t0, t1); *(u32x4*)(MG + off) = pack8(v0 + t0, v1 + t1); } }
        )
    }
};
struct EpiOut {
    static constexpr bool PERM = false, AFTER_DRAIN = false;
    const float* X; float* O;
    __device__ __forceinline__ void operator()(const f32x4 (&acc)[2][2][4][2], const Unit& u, int wr, int wc, int fr, int fq) const {
        const int row0 = u.pm * BM + wr * 64 + fr, col0 = u.pn * BM + wc * 32 + 4 * fq;
        EPI_ROWS(
            _Pragma("unroll") for (int bj = 0; bj < 2; ++bj) _Pragma("unroll") for (int n = 0; n < 2; ++n) { const size_t off = (size_t)row * 2048 + col0 + bj * HALF + n * 16;
                *(f32x4*)(O + off) = *(const f32x4*)(X + off) + acc[ai][bj][m][n]; }
        )
    }
};
struct EpiMoeUp {
    static constexpr bool PERM = true, AFTER_DRAIN = false;
    bf16_t* ACT;
    __device__ __forceinline__ void operator()(const f32x4 (&acc)[2][2][4][2], const Unit& u, int wr, int wc, int fr, int fq) const {
        const int row0 = u.pm * BM + wr * 64 + fr, col0 = (u.pn & 3) * HALF + wc * 32 + 8 * fq;
        EPI_ROWS(
            f32x4 v0, v1;
            _Pragma("unroll") for (int e = 0; e < 4; ++e) { const float g0 = acc[ai][0][m][0][e], g1 = acc[ai][0][m][1][e];
                v0[e] = g0 * fsig(g0) * acc[ai][1][m][0][e]; v1[e] = g1 * fsig(g1) * acc[ai][1][m][1][e]; }
            *(u32x4*)(ACT + (size_t)row * 512 + col0) = pack8(v0, v1);
        )
    }
};
struct EpiMoeDown {
    static constexpr bool PERM = true, AFTER_DRAIN = false;
    const int* slot_of; const float* slot_w; bf16_t* Y;
    __device__ __forceinline__ void operator()(const f32x4 (&acc)[2][2][4][2], const Unit& u, int wr, int wc, int fr, int fq) const {
        const int row0 = u.pm * BM + wr * 64 + fr, col0 = (u.pn & 7) * BM + wc * 32 + 8 * fq;
        EPI_ROWS(
            const int slot = slot_of[row]; const float w = slot_w[row];
            if (slot >= 0) { _Pragma("unroll") for (int bj = 0; bj < 2; ++bj) *(u32x4*)(Y + (size_t)slot * 2048 + col0 + bj * HALF) = pack8(acc[ai][bj][m][0] * w, acc[ai][bj][m][1] * w); }
        )
    }
};
struct MoeOrder {
    const PG8_LAS int* rt_start; int ncol, G, c;
    __device__ __forceinline__ bool next(int i, Unit& u) const {
        const int L = i * G + c, total = rt_start[32] * ncol; if (L >= total) return false;
        const int rt = L / ncol, ct = L - rt * ncol; int e = 0;
#pragma unroll
        for (int k = 1; k < 32; ++k) e += (rt >= rt_start[k]) ? 1 : 0;
        u.pm = rt; u.pn = e * ncol + ct; return true;
    }
    __device__ __forceinline__ void a_ready(const Unit&) const {}
    __device__ __forceinline__ void done(const Unit&) const {}
};
template <class Epi, class Sched, bool ALIGN_EPI = false, bool SP2 = false>
__device__ __forceinline__ void gemm_phase(PG8_LAS unsigned char* lds, const Gemm g, const Sched& S, const Epi& E) {
    const int tid = threadIdx.x, wid = __builtin_amdgcn_readfirstlane(tid >> 6), lane = tid & 63, wr = wid >> 2, wc = wid & 3, fr = lane & 15, fq = lane >> 4;
    const int K = g.K, nt = K / BK;
    unsigned voffA[2], voffB[2];
#pragma unroll
    for (int i = 0; i < 2; ++i) { int R, C; stage_rc(tid * 16 + i * 8192, R, C); const int Rb = Epi::PERM ? ((R & ~31) + perm32(R & 31)) : R;
        voffA[i] = (unsigned)(R * K + C) * 2u; voffB[i] = (unsigned)(Rb * K + C) * 2u; }
    const size_t kstep = (size_t)(BK * 2);
    const size_t hstep = (size_t)HALF * K * 2;
    const size_t tstep = 2 * hstep;
    const unsigned ldsw = (unsigned)wid * 1024u;
    const int aoff = lds_byte(wr * 64 + fr, fq * 8), boff = lds_byte(wc * 32 + fr, fq * 8);
#define PG8_SA(b, h) (((b) * 2 + (h)) * HTB)
#define PG8_SB(b, h) ((4 + (b) * 2 + (h)) * HTB)
#define PG8_STAGE(bufoff, gbase, voff) do { _Pragma("unroll") for (int _i = 0; _i < 2; ++_i) \
        __builtin_amdgcn_global_load_lds((const unsigned*)((const char*)(gbase) + (voff)[_i]), (PG8_LAS unsigned*)(lds + (bufoff) + ldsw + _i * 8192), 16, 0, 0); } while (0)
#define PG8_LDA(dst, b, h) do { _Pragma("unroll") for (int m = 0; m < 4; ++m) _Pragma("unroll") for (int k = 0; k < 2; ++k) dst[m][k] = *(const PG8_LAS bf16x8*)(lds + PG8_SA(b, h) + aoff + m * 2048 + k * 1024); } while (0)
#define PG8_LDB(dst, b, h) do { _Pragma("unroll") for (int n = 0; n < 2; ++n) _Pragma("unroll") for (int k = 0; k < 2; ++k) dst[n][k] = *(const PG8_LAS bf16x8*)(lds + PG8_SB(b, h) + boff + n * 2048 + k * 1024); } while (0)
#define PG8_MMA(ai, bj, At, Bt) do { __builtin_amdgcn_s_setprio(1); _Pragma("unroll") for (int m = 0; m < 4; ++m) _Pragma("unroll") for (int n = 0; n < 2; ++n) _Pragma("unroll") for (int k = 0; k < 2; ++k) \
        acc[ai][bj][m][n] = __builtin_amdgcn_mfma_f32_16x16x32_bf16(Bt[n][k], At[m][k], acc[ai][bj][m][n], 0, 0, 0); __builtin_amdgcn_s_setprio(0); } while (0)
#define PG8_WAIT_V(n) asm volatile("s_waitcnt vmcnt(" #n ")" ::: "memory")
#define PG8_WAIT_L(n) asm volatile("s_waitcnt lgkmcnt(" #n ")" ::: "memory")
#define PG8_BAR __builtin_amdgcn_s_barrier()
#define PG8_SCHED __builtin_amdgcn_sched_barrier(0)
    Unit cur, nxt; int ui = 0;
    if (!S.next(0, cur)) return;
    f32x4 acc[2][2][4][2];
#pragma unroll
    for (int a = 0; a < 2; ++a)
#pragma unroll
        for (int b = 0; b < 2; ++b)
#pragma unroll
            for (int m = 0; m < 4; ++m)
#pragma unroll
                for (int n = 0; n < 2; ++n) acc[a][b][m][n] = (f32x4){0.f, 0.f, 0.f, 0.f};
    bf16x8 At[4][2], B0[2][2], B1[2][2];
    const char* cA = (const char*)g.A + (size_t)cur.pm * tstep; const char* cB = (const char*)g.Bt + (size_t)cur.pn * tstep;
    S.a_ready(cur);
    if constexpr (SP2) {
        PG8_STAGE(PG8_SB(0, 0), cB, voffB); PG8_STAGE(PG8_SB(0, 1), cB + hstep, voffB); PG8_STAGE(PG8_SA(0, 0), cA, voffA); PG8_STAGE(PG8_SA(0, 1), cA + hstep, voffA);
        if (wr == 1) PG8_BAR;
        PG8_WAIT_V(2); PG8_BAR;
        PG8_STAGE(PG8_SB(1, 0), cB + kstep, voffB); PG8_STAGE(PG8_SA(1, 0), cA + kstep, voffA); PG8_STAGE(PG8_SB(1, 1), cB + hstep + kstep, voffB);
        PG8_WAIT_V(6); PG8_BAR;
    } else {
        PG8_STAGE(PG8_SB(0, 0), cB, voffB); PG8_STAGE(PG8_SA(0, 0), cA, voffA); PG8_STAGE(PG8_SB(0, 1), cB + hstep, voffB); PG8_STAGE(PG8_SA(0, 1), cA + hstep, voffA);
        if (wr == 1) PG8_BAR;
        PG8_WAIT_V(4); PG8_BAR;
        PG8_STAGE(PG8_SB(1, 0), cB + kstep, voffB); PG8_STAGE(PG8_SA(1, 0), cA + kstep, voffA); PG8_STAGE(PG8_SB(1, 1), cB + hstep + kstep, voffB);
        PG8_WAIT_V(6); PG8_BAR;
    }
    for (;;) {
        const bool has_next = S.next(ui + 1, nxt);
        const char* nA = has_next ? (const char*)g.A + (size_t)nxt.pm * tstep : cA; const char* nB = has_next ? (const char*)g.Bt + (size_t)nxt.pn * tstep : cB;
        for (int t = 0; t < nt; t += 2) {
            const bool last = (t == nt - 2);
            const char* a1 = cA + (size_t)(t + 1) * kstep;
            const char* a2 = last ? nA : cA + (size_t)(t + 2) * kstep; const char* b2 = last ? nB : cB + (size_t)(t + 2) * kstep;
            const char* a3 = a2 + kstep; const char* b3 = b2 + kstep;
            if (last && has_next) S.a_ready(nxt);
            if constexpr (SP2) {
            PG8_LDB(B0, 0, 0); PG8_LDB(B1, 0, 1); PG8_SCHED; PG8_LDA(At, 0, 0); PG8_STAGE(PG8_SA(1, 1), a1 + hstep, voffA);
            PG8_WAIT_V(8); PG8_WAIT_L(0); PG8_BAR; PG8_MMA(0, 0, At, B0); PG8_MMA(0, 1, At, B1); PG8_BAR; PG8_SCHED;
            PG8_LDA(At, 0, 1); PG8_STAGE(PG8_SB(0, 0), b2, voffB); PG8_STAGE(PG8_SB(0, 1), b2 + hstep, voffB); PG8_STAGE(PG8_SA(0, 0), a2, voffA);
            PG8_WAIT_V(8); PG8_WAIT_L(0); PG8_BAR; PG8_MMA(1, 0, At, B0); PG8_MMA(1, 1, At, B1); PG8_BAR; PG8_SCHED;
            PG8_LDB(B0, 1, 0); PG8_LDB(B1, 1, 1); PG8_SCHED; PG8_LDA(At, 1, 0); PG8_STAGE(PG8_SA(0, 1), a2 + hstep, voffA);
            PG8_WAIT_V(8); PG8_WAIT_L(0); PG8_BAR; PG8_MMA(0, 0, At, B0); PG8_MMA(0, 1, At, B1); PG8_BAR; PG8_SCHED;
            PG8_LDA(At, 1, 1); PG8_STAGE(PG8_SB(1, 0), b3, voffB); PG8_STAGE(PG8_SB(1, 1), b3 + hstep, voffB); PG8_STAGE(PG8_SA(1, 0), a3, voffA);
            PG8_WAIT_V(8); PG8_WAIT_L(0); PG8_BAR; PG8_MMA(1, 0, At, B0); PG8_MMA(1, 1, At, B1); PG8_BAR; PG8_SCHED;
            } else {
            PG8_LDB(B0, 0, 0); PG8_SCHED; PG8_LDA(At, 0, 0); PG8_STAGE(PG8_SA(1, 1), a1 + hstep, voffA);
            PG8_WAIT_L(8); PG8_BAR; PG8_WAIT_L(0); PG8_MMA(0, 0, At, B0); PG8_BAR; PG8_SCHED;
            PG8_LDB(B1, 0, 1); PG8_STAGE(PG8_SB(0, 0), b2, voffB);
            PG8_BAR; PG8_WAIT_L(0); PG8_MMA(0, 1, At, B1); PG8_BAR;
            PG8_LDA(At, 0, 1); PG8_STAGE(PG8_SA(0, 0), a2, voffA);
            PG8_BAR; PG8_WAIT_L(0); PG8_MMA(1, 0, At, B0); PG8_BAR; PG8_SCHED;
            PG8_STAGE(PG8_SB(0, 1), b2 + hstep, voffB);
            PG8_WAIT_V(6); PG8_BAR; PG8_MMA(1, 1, At, B1); PG8_BAR;
            PG8_LDB(B0, 1, 0); PG8_SCHED; PG8_LDA(At, 1, 0); PG8_STAGE(PG8_SA(0, 1), a2 + hstep, voffA);
            PG8_WAIT_L(8); PG8_BAR; PG8_WAIT_L(0); PG8_MMA(0, 0, At, B0); PG8_BAR; PG8_SCHED;
            PG8_LDB(B1, 1, 1); PG8_STAGE(PG8_SB(1, 0), b3, voffB);
            PG8_BAR; PG8_WAIT_L(0); PG8_MMA(0, 1, At, B1); PG8_BAR;
            PG8_LDA(At, 1, 1); PG8_STAGE(PG8_SA(1, 0), a3, voffA);
            PG8_BAR; PG8_WAIT_L(0); PG8_MMA(1, 0, At, B0); PG8_BAR; PG8_SCHED;
            PG8_STAGE(PG8_SB(1, 1), b3 + hstep, voffB);
            PG8_WAIT_V(6); PG8_BAR; PG8_MMA(1, 1, At, B1); PG8_BAR;
            }
        }
        if constexpr (ALIGN_EPI) { if (wr == 0) PG8_BAR; }
        if constexpr (!Epi::AFTER_DRAIN) { E(acc, cur, wr, wc, fr, fq); S.done(cur); }
        if (!has_next) break;
#pragma unroll
        for (int a = 0; a < 2; ++a)
#pragma unroll
            for (int b = 0; b < 2; ++b)
#pragma unroll
                for (int m = 0; m < 4; ++m)
#pragma unroll
                    for (int n = 0; n < 2; ++n) acc[a][b][m][n] = (f32x4){0.f, 0.f, 0.f, 0.f};
        cur = nxt; cA = nA; cB = nB; ++ui;
        if constexpr (ALIGN_EPI) { if (wr == 1) PG8_BAR; }
    }
    PG8_WAIT_V(0);
    if constexpr (!ALIGN_EPI) { if (wr == 0) PG8_BAR; }
    PG8_BAR;
    if constexpr (Epi::AFTER_DRAIN) { E.fused(acc, cur, wr, wc, fr, fq, lds, wid, lane); S.done(cur); }
#undef PG8_SA
#undef PG8_SB
#undef PG8_STAGE
#undef PG8_LDA
#undef PG8_LDB
#undef PG8_MMA
#undef PG8_WAIT_V
#undef PG8_WAIT_L
#undef PG8_BAR
#undef PG8_SCHED
}
}

namespace att {
#define ATT_LAS __attribute__((address_space(3)))
typedef unsigned short bf16_t;
typedef short bf16x8 __attribute__((ext_vector_type(8)));
typedef short s16x4 __attribute__((ext_vector_type(4)));
typedef float f32x16 __attribute__((ext_vector_type(16)));
typedef float f32x4 __attribute__((ext_vector_type(4)));
typedef unsigned u32x4 __attribute__((ext_vector_type(4)));
constexpr int NW = 8, QBLK = 32, KVBLK = 64, QB = 128, PITCH = 8192;
constexpr int SHM_V = KVBLK * 128 * 2, SHM_K = KVBLK * 128 * 2;
constexpr int LDS_BYTES = 2 * SHM_V + 2 * SHM_K + NW * 64 * 4;
constexpr float SCALE = 0.125f, THR = 8.f;
#define KSWZ(row, colB) ((row) * 256 + ((colB) ^ (((row) & 7) << 4)))
#define SBAR() __builtin_amdgcn_sched_barrier(0)
__device__ __forceinline__ int v_st(int k, int c) { const int kk = (k & ~0xC) | ((k & 4) << 1) | ((k & 8) >> 1); return ((kk >> 3) * 4 + (c >> 5)) * 512 + ((kk & 7) * 32 + (c & 31)) * 2; }
__device__ __forceinline__ int v_rd_base(int lane) { return ((lane & 3) << 3) | (((lane >> 2) & 3) << 6) | (((lane >> 4) & 1) << 5) | (((lane >> 5) & 1) << 8); }
constexpr int v_rd_off(int d0, int ks, int half) { return d0 * 512 + ks * 4096 + half * 2048; }
__device__ __forceinline__ int crow(int r, int hi) { return (r & 3) + 8 * (r >> 2) + 4 * hi; }
__device__ __forceinline__ unsigned cvtpk(float lo, float hi) { unsigned r; asm volatile("v_cvt_pk_bf16_f32 %0, %1, %2" : "=v"(r) : "v"(lo), "v"(hi)); return r; }
__device__ __forceinline__ void mask_tile(f32x16& p0, f32x16& p1, int dq) {
    const float NEG = -__builtin_inff();
#pragma unroll
    for (int r = 0; r < 16; ++r) { const int c = (r & 3) + 8 * (r >> 2); if (dq - c < 0) p0[r] = NEG; if (dq - c - 32 < 0) p1[r] = NEG; }
}
__device__ __forceinline__ void partialSM(f32x16& p0, f32x16& p1, float& m_reg, float& mn, float& alpha) {
    float pmax = p0[0];
#pragma unroll
    for (int r = 1; r < 16; ++r) pmax = fmaxf(pmax, p0[r]);
#pragma unroll
    for (int r = 0; r < 16; ++r) pmax = fmaxf(pmax, p1[r]);
    { auto rr = __builtin_amdgcn_permlane32_swap(__float_as_uint(pmax), __float_as_uint(pmax), false, false);
      pmax = fmaxf(__uint_as_float(rr[0]), __uint_as_float(rr[1])); }
    constexpr float C2 = 1.4426950408889634f * SCALE;
    if (__builtin_expect(__all((pmax - m_reg) * SCALE <= THR), 1)) { mn = m_reg; alpha = 1.f; }
    else { mn = fmaxf(m_reg, pmax); alpha = __builtin_amdgcn_exp2f((m_reg - mn) * C2); m_reg = mn; }
    const float mnL = -mn * C2;
#pragma unroll
    for (int r = 0; r < 16; ++r) p0[r] = fmaf(p0[r], C2, mnL);
#pragma unroll
    for (int r = 0; r < 16; ++r) p1[r] = fmaf(p1[r], C2, mnL);
#pragma unroll
    for (int r = 0; r < 16; ++r) p0[r] = __builtin_amdgcn_exp2f(p0[r]);
}
__device__ __forceinline__ void finishSM(f32x16& p0, f32x16& p1, float alpha, float& l_reg, bf16x8& pa0, bf16x8& pa1, bf16x8& pa2, bf16x8& pa3) {
#pragma unroll
    for (int r = 0; r < 16; ++r) p1[r] = __builtin_amdgcn_exp2f(p1[r]);
    float ps = 0;
#pragma unroll
    for (int r = 0; r < 16; ++r) ps += p0[r];
#pragma unroll
    for (int r = 0; r < 16; ++r) ps += p1[r];
    { auto rr = __builtin_amdgcn_permlane32_swap(__float_as_uint(ps), __float_as_uint(ps), false, false);
      ps = __uint_as_float(rr[0]) + __uint_as_float(rr[1]); }
    l_reg = l_reg * alpha + ps;
#define PK4(P, B_, OUT) do { unsigned a0 = cvtpk(P[B_+0], P[B_+1]), a1 = cvtpk(P[B_+2], P[B_+3]);                          \
        unsigned b0 = cvtpk(P[B_+4], P[B_+5]), b1 = cvtpk(P[B_+6], P[B_+7]);                                             \
        auto r0 = __builtin_amdgcn_permlane32_swap(a0, b0, false, false); auto r1 = __builtin_amdgcn_permlane32_swap(a1, b1, false, false); \
        u32x4 w = {r0[0], r1[0], r0[1], r1[1]}; OUT = __builtin_bit_cast(bf16x8, w); } while (0)
    PK4(p0, 0, pa0); PK4(p0, 8, pa1); PK4(p1, 0, pa2); PK4(p1, 8, pa3);
#undef PK4
}
template <int KB>
__device__ __forceinline__ void qkt(f32x16& p0, f32x16& p1, const ATT_LAS char* K_lds, int r32, int hi, int cofs, const bf16x8* qr) {
    p0 = f32x16{}; p1 = f32x16{};
#pragma unroll
    for (int d0 = 0; d0 < 4; ++d0) { const ATT_LAS char* a = K_lds + KB * SHM_K + KSWZ(r32, (d0 * 16 + hi * 8) * 2) + cofs;
        const bf16x8 b0 = *reinterpret_cast<const ATT_LAS bf16x8*>(a);
        const bf16x8 b1 = *reinterpret_cast<const ATT_LAS bf16x8*>(a + 32 * 256);
        p0 = __builtin_amdgcn_mfma_f32_32x32x16_bf16(b0, qr[d0], p0, 0, 0, 0);
        p1 = __builtin_amdgcn_mfma_f32_32x32x16_bf16(b1, qr[d0], p1, 0, 0, 0); }
}
template <int VB>
__device__ __forceinline__ void pv_tile(f32x16* o, int vb0, bf16x8 pa0, bf16x8 pa1, bf16x8 pa2, bf16x8 pa3) {
#define TRRD(dst, off) asm volatile("ds_read_b64_tr_b16 %0, %1 offset:%2" : "=&v"(dst) : "v"(vb0), "i"(off) : "memory")
#define PV_D0(d0) do { s16x4 l0, l1, l2, l3, h0, h1, h2, h3; constexpr int b_ = VB * SHM_V + v_rd_off(d0, 0, 0); \
        TRRD(l0, b_); TRRD(h0, b_ + 2048); TRRD(l1, b_ + 4096); TRRD(h1, b_ + 6144); TRRD(l2, b_ + 8192); TRRD(h2, b_ + 10240); TRRD(l3, b_ + 12288); TRRD(h3, b_ + 14336); \
        asm volatile("s_waitcnt lgkmcnt(0)" ::: "memory"); SBAR();   \
        o[d0] = __builtin_amdgcn_mfma_f32_32x32x16_bf16(pa0, (bf16x8){l0[0], l0[1], l0[2], l0[3], h0[0], h0[1], h0[2], h0[3]}, o[d0], 0, 0, 0);   \
        o[d0] = __builtin_amdgcn_mfma_f32_32x32x16_bf16(pa1, (bf16x8){l1[0], l1[1], l1[2], l1[3], h1[0], h1[1], h1[2], h1[3]}, o[d0], 0, 0, 0);   \
        o[d0] = __builtin_amdgcn_mfma_f32_32x32x16_bf16(pa2, (bf16x8){l2[0], l2[1], l2[2], l2[3], h2[0], h2[1], h2[2], h2[3]}, o[d0], 0, 0, 0);   \
        o[d0] = __builtin_amdgcn_mfma_f32_32x32x16_bf16(pa3, (bf16x8){l3[0], l3[1], l3[2], l3[3], h3[0], h3[1], h3[2], h3[3]}, o[d0], 0, 0, 0); } while (0)
    PV_D0(0); PV_D0(1); PV_D0(2); PV_D0(3);
#undef PV_D0
#undef TRRD
}
__device__ __forceinline__ void attn_block(int h, int qb, const bf16_t* Z, int ZQ, int ZK, int ZV, float lam, const float* subw, bf16_t* YA, ATT_LAS char* lds) {
    const int tid = threadIdx.x, wid = __builtin_amdgcn_readfirstlane(tid >> 6), lane = tid & 63, r32 = lane & 31, hi = lane >> 5;
    const int wq = wid & 3, cm = wid >> 2, cofs = cm * 128;
    const int P0 = qb * QB, NT = (P0 + QB - 1) / KVBLK + 1;
    const int qlo = P0 + wq * QBLK, qm = qlo + r32 - 4 * hi;
    ATT_LAS char* V_lds = lds; ATT_LAS char* K_lds = lds + 2 * SHM_V;
    ATT_LAS float* ws = (ATT_LAS float*)(lds + 2 * SHM_V + 2 * SHM_K) + wid * 64; ATT_LAS float* li_l = ws; ATT_LAS float* al_l = ws + 32;
    float m_reg = -1e30f, l_reg = 0; f32x16 o[4] = {};
    const int sr = tid >> 4, sc = (tid & 15) * 8, vst0 = v_st(sr, sc), vst1 = v_st(32 + sr, sc), kws = KSWZ(sr, sc * 2);
    const int vb0 = (int)(unsigned)(uintptr_t)V_lds + v_rd_base(lane);
    const bf16_t* Kh = Z + ZK + h * 128; const bf16_t* Vh = Z + ZV + h * 128;
    bf16x8 st_v0, st_v1, st_k0, st_k1;
#define ROW(p, k0, rr) ((p) + (size_t)((k0) + (rr)) * PITCH + sc)
#define VMW() asm volatile("s_waitcnt vmcnt(0)" ::: "memory")
#define SLOAD_H(k0) do { st_v0 = *(const bf16x8*)ROW(Vh, k0, sr); st_v1 = *(const bf16x8*)ROW(Vh, k0, 32 + sr); st_k0 = *(const bf16x8*)ROW(Kh, k0, sr); st_k1 = *(const bf16x8*)ROW(Kh, k0, 32 + sr); } while (0)
#define SWRITE_H(bf) do { *(ATT_LAS bf16x8*)(V_lds + (bf) * SHM_V + vst0) = st_v0; *(ATT_LAS bf16x8*)(V_lds + (bf) * SHM_V + vst1) = st_v1; \
                          *(ATT_LAS bf16x8*)(K_lds + (bf) * SHM_K + kws) = st_k0; *(ATT_LAS bf16x8*)(K_lds + (bf) * SHM_K + kws + 32 * 256) = st_k1; } while (0)
#define RESC(a) do { if (__any((a) < 1.f)) { if (hi == 0) al_l[r32] = (a); asm volatile("s_waitcnt lgkmcnt(0)" ::: "memory");              \
                     _Pragma("unroll") for (int d_ = 0; d_ < 4; ++d_) _Pragma("unroll") for (int r = 0; r < 16; ++r) o[d_][r] *= al_l[crow(r, hi)]; } } while (0)
#define KBASE(t) ((t) * KVBLK)
#define MASKT(P0_, P1_, t) do { const int kb_ = KBASE(t); if (kb_ + KVBLK - 1 > qlo) mask_tile(P0_, P1_, qm - kb_); } while (0)
    bf16x8 qr[4];
    SLOAD_H(0);
#pragma unroll
    for (int d0 = 0; d0 < 4; ++d0) qr[d0] = *(const bf16x8*)(Z + ZQ + h * 128 + cm * 64 + (size_t)(qlo + r32) * PITCH + d0 * 16 + hi * 8);
    VMW(); SWRITE_H(0);
    __syncthreads();
    f32x16 pA0, pA1, pB0, pB1; float mnA, mnB, alA, alB; bf16x8 pa0, pa1, pa2, pa3;
    if (NT > 1) SLOAD_H(KBASE(1));
    SBAR(); qkt<0>(pA0, pA1, K_lds, r32, hi, cofs, qr);
    MASKT(pA0, pA1, 0); partialSM(pA0, pA1, m_reg, mnA, alA);
    if (NT > 1) { VMW(); SWRITE_H(1); }
    __syncthreads();
#define HALF_STEP(PX0, PX1, mnX, alX, PY0, PY1, alY, t, KB, VB, SB) do {                                                      \
        SBAR(); qkt<KB>(PX0, PX1, K_lds, r32, hi, cofs, qr);                                                                   \
        finishSM(PY0, PY1, alY, l_reg, pa0, pa1, pa2, pa3); SBAR();                                                           \
        if ((t) + 1 < NT) { SLOAD_H(KBASE((t) + 1)); SBAR(); }                                                                \
        pv_tile<VB>(o, vb0, pa0, pa1, pa2, pa3); MASKT(PX0, PX1, (t)); partialSM(PX0, PX1, m_reg, mnX, alX);                  \
        __syncthreads();                                                                                                      \
        if ((t) + 1 < NT) { VMW(); SWRITE_H(SB); }                                                                            \
        RESC(alX); __syncthreads(); } while (0)
    for (int t = 1; t + 1 < NT; t += 2) {
        HALF_STEP(pB0, pB1, mnB, alB, pA0, pA1, alA, t, 1, 0, 0);
        HALF_STEP(pA0, pA1, mnA, alA, pB0, pB1, alB, t + 1, 0, 1, 1);
    }
    const bool even = (NT & 1) == 0;
    if (even) { SBAR(); qkt<1>(pB0, pB1, K_lds, r32, hi, cofs, qr); SBAR(); }
    finishSM(pA0, pA1, alA, l_reg, pa0, pa1, pa2, pa3); SBAR();
    pv_tile<0>(o, vb0, pa0, pa1, pa2, pa3);
    if (even) { MASKT(pB0, pB1, NT - 1); partialSM(pB0, pB1, m_reg, mnB, alB); RESC(alB);
        finishSM(pB0, pB1, alB, l_reg, pa0, pa1, pa2, pa3); SBAR(); pv_tile<1>(o, vb0, pa0, pa1, pa2, pa3); }
    if (hi == 0) li_l[r32] = l_reg; asm volatile("s_waitcnt lgkmcnt(0)" ::: "memory");
    float rli[16];
#pragma unroll
    for (int r = 0; r < 16; ++r) rli[r] = __builtin_amdgcn_rcpf(li_l[crow(r, hi)]);
    __syncthreads();
    ATT_LAS float* X = (ATT_LAS float*)lds + wq * 4096;
    if (cm == 1) {
#pragma unroll
        for (int d0 = 0; d0 < 4; ++d0)
#pragma unroll
            for (int r = 0; r < 16; ++r) X[(d0 * 16 + r) * 64 + lane] = lam * o[d0][r] * rli[r];
    }
    __syncthreads();
    if (cm == 0) {
        float ss[16];
#pragma unroll
        for (int r = 0; r < 16; ++r) { float s = 0.f;
#pragma unroll
            for (int d0 = 0; d0 < 4; ++d0) { const float v = o[d0][r] * rli[r] - X[(d0 * 16 + r) * 64 + lane]; o[d0][r] = v; s += v * v; }
            ss[r] = s; }
#pragma unroll
        for (int sh = 1; sh < 32; sh <<= 1)
#pragma unroll
            for (int r = 0; r < 16; ++r) ss[r] += __shfl_xor(ss[r], sh);
        float sw[4];
#pragma unroll
        for (int d0 = 0; d0 < 4; ++d0) sw[d0] = subw[d0 * 32 + r32] * 0.8f;
#pragma unroll
        for (int r = 0; r < 16; ++r) { const float rs = __builtin_amdgcn_rsqf(ss[r] * (1.f / 128.f) + 1e-5f);
            unsigned short* yp = YA + (size_t)(qlo + crow(r, hi)) * 1024 + h * 128 + r32;
#pragma unroll
            for (int d0 = 0; d0 < 4; ++d0) { const unsigned w = cvtpk(o[d0][r] * rs * sw[d0], 0.f); yp[d0 * 32] = (unsigned short)(w & 0xffffu); } }
    }
    __syncthreads();
#undef ROW
#undef VMW
#undef SLOAD_H
#undef SWRITE_H
#undef RESC
#undef KBASE
#undef MASKT
#undef HALF_STEP
}
#undef KSWZ
#undef SBAR
}

namespace ssm {
#define SSM_LAS __attribute__((address_space(3)))
typedef unsigned short bf16_t;
typedef short bf16x8 __attribute__((ext_vector_type(8)));
typedef float f32x16 __attribute__((ext_vector_type(16)));
typedef float f32x4 __attribute__((ext_vector_type(4)));
typedef float f32x2 __attribute__((ext_vector_type(2)));
typedef unsigned u32x2 __attribute__((ext_vector_type(2)));
constexpr int RUN = 256, NRUN = 32, XROW = 272;
constexpr int WAVE_LDS = 32 * XROW;
__device__ __forceinline__ unsigned cvtpk(float lo, float hi) { unsigned r; asm volatile("v_cvt_pk_bf16_f32 %0, %1, %2" : "=v"(r) : "v"(lo), "v"(hi)); return r; }
__device__ __forceinline__ float bf_lo(unsigned w) { return __builtin_bit_cast(float, w << 16); }
__device__ __forceinline__ float bf_hi(unsigned w) { return __builtin_bit_cast(float, w & 0xffff0000u); }
__device__ __forceinline__ float gelu_tanh(float x) {
    const float z2 = 2.f * 0.7978845608028654f * (x + 0.044715f * x * x * x);
    return x * __builtin_amdgcn_rcpf(1.f + __builtin_amdgcn_exp2f(-1.4426950408889634f * z2));
}
template <bool PASS2>
__device__ __forceinline__ void run_item(int g, int r, int lane, const bf16_t* Z  , const f32x2* abar, const bf16_t* BbarT, const bf16_t* CmatT,
                                         const float* dskip, f32x2* E, bf16_t* YP, SSM_LAS char* xl) {
    const int hi = lane >> 5, c32 = lane & 31;
    const f32x2 a = abar[g * 64 + lane]; const float ar = a.x, ai = a.y;
    const bf16x8 bre0 = *(const bf16x8*)(BbarT + ((size_t)((g * 2 + 0) * 64 + c32) * 16 + 8 * hi));
    const bf16x8 bre1 = *(const bf16x8*)(BbarT + ((size_t)((g * 2 + 0) * 64 + 32 + c32) * 16 + 8 * hi));
    const bf16x8 bim0 = *(const bf16x8*)(BbarT + ((size_t)((g * 2 + 1) * 64 + c32) * 16 + 8 * hi));
    const bf16x8 bim1 = *(const bf16x8*)(BbarT + ((size_t)((g * 2 + 1) * 64 + 32 + c32) * 16 + 8 * hi));
    float xr = 0.f, xi = 0.f;
    bf16x8 cop[4]; f32x4 d4 = (f32x4){0.f, 0.f, 0.f, 0.f};
    if (PASS2) {
        float pr = ar, pi = ai;
#pragma unroll
        for (int s = 0; s < 8; ++s) { const float nr = pr * pr - pi * pi, ni = 2.f * pr * pi; pr = nr; pi = ni; }
        for (int j = 0; j < r; ++j) { const f32x2 e = E[(size_t)(g * NRUN + j) * 64 + lane]; const float nr = pr * xr - pi * xi + e.x, ni = pr * xi + pi * xr + e.y; xr = nr; xi = ni; }
#pragma unroll
        for (int kk = 0; kk < 4; ++kk) cop[kk] = *(const bf16x8*)(CmatT + ((size_t)(g * 16 + (lane & 15)) * 128 + 32 * kk + 8 * (lane >> 4)));
        d4 = *(const f32x4*)(dskip + g * 16 + 4 * (lane >> 4));
    }
    for (int blk = 0; blk < RUN / 32; ++blk) {
        const int t0 = r * RUN + blk * 32;
        const bf16x8 ua = *(const bf16x8*)(Z + (size_t)(t0 + c32) * 8192 + g * 16 + 8 * hi);
        f32x16 Are = __builtin_amdgcn_mfma_f32_32x32x16_bf16(ua, bre0, f32x16{}, 0, 0, 0);
        f32x16 Bre = __builtin_amdgcn_mfma_f32_32x32x16_bf16(ua, bre1, f32x16{}, 0, 0, 0);
        f32x16 Aim = __builtin_amdgcn_mfma_f32_32x32x16_bf16(ua, bim0, f32x16{}, 0, 0, 0);
        f32x16 Bim = __builtin_amdgcn_mfma_f32_32x32x16_bf16(ua, bim1, f32x16{}, 0, 0, 0);
#pragma unroll
        for (int q = 0; q < 16; ++q) {
            auto s0 = __builtin_amdgcn_permlane32_swap(__float_as_uint(Are[q]), __float_as_uint(Bre[q]), false, false); Are[q] = __uint_as_float(s0[0]); Bre[q] = __uint_as_float(s0[1]);
            auto s1 = __builtin_amdgcn_permlane32_swap(__float_as_uint(Aim[q]), __float_as_uint(Bim[q]), false, false); Aim[q] = __uint_as_float(s1[0]); Bim[q] = __uint_as_float(s1[1]);
        }
#pragma unroll
        for (int q = 0; q < 4; ++q)
#pragma unroll
            for (int h2 = 0; h2 < 2; ++h2)
#pragma unroll
                for (int i = 0; i < 4; ++i) {
                    const int reg = 4 * q + i, tl = 8 * q + 4 * h2 + i;
                    const float bur = h2 ? Bre[reg] : Are[reg], bui = h2 ? Bim[reg] : Aim[reg];
                    const float nr = fmaf(ar, xr, fmaf(-ai, xi, bur)), ni = fmaf(ar, xi, fmaf(ai, xr, bui));
                    xr = nr; xi = ni;
                    if (PASS2) *(SSM_LAS unsigned*)(xl + tl * XROW + 4 * lane) = cvtpk(xr, xi);
                }
        if (PASS2) {
#pragma unroll
            for (int tb = 0; tb < 2; ++tb) {
                f32x4 acc = (f32x4){0.f, 0.f, 0.f, 0.f};
#pragma unroll
                for (int kk = 0; kk < 4; ++kk) { const bf16x8 bx = *(const SSM_LAS bf16x8*)(xl + (16 * tb + (lane & 15)) * XROW + 64 * kk + 16 * (lane >> 4));
                    acc = __builtin_amdgcn_mfma_f32_16x16x32_bf16(cop[kk], bx, acc, 0, 0, 0); }
                const int t = t0 + 16 * tb + (lane & 15), m0 = 4 * (lane >> 4);
                const u32x2 uw = *(const u32x2*)(Z + (size_t)t * 8192 + g * 16 + m0);
                const float y0 = gelu_tanh(acc[0] + d4[0] * bf_lo(uw.x)), y1 = gelu_tanh(acc[1] + d4[1] * bf_hi(uw.x));
                const float y2 = gelu_tanh(acc[2] + d4[2] * bf_lo(uw.y)), y3 = gelu_tanh(acc[3] + d4[3] * bf_hi(uw.y));
                u32x2 ow; ow.x = cvtpk(y0, y1); ow.y = cvtpk(y2, y3);
                *(u32x2*)(YP + (size_t)t * 1024 + g * 16 + m0) = ow;
            }
        }
    }
    if (!PASS2) E[(size_t)(g * NRUN + r) * 64 + lane] = (f32x2){xr, xi};
}
}

constexpr int NWAVES = 8;
constexpr int S_ = 8192, DM = 2048, INW = 8192;
constexpr int ZU = 0, ZQ = 1024, ZK = 2048, ZV = 3072, ZGS = 4096, ZGA = 6144;
constexpr int NEXP = 32, DFF = 512;
constexpr int XG_ROWS = 2 * S_ + NEXP * 256;
constexpr size_t MiB = 1u << 20;
constexpr size_t WS_CTL = 0, CTL_ZERO_BYTES = 1 * MiB;
constexpr size_t WS_ROPE = 2 * MiB;
constexpr size_t WS_SSMT = 4 * MiB;
constexpr size_t WS_ROUTE = 6 * MiB;
constexpr size_t WS_WIN = 8 * MiB;
constexpr size_t WS_WGLU = 40 * MiB;
constexpr size_t WS_WPS = 42 * MiB, WS_WPA = 46 * MiB;
constexpr size_t WS_WOUT = 50 * MiB;
constexpr size_t WS_WGU = 58 * MiB;
constexpr size_t WS_WD = 186 * MiB;
constexpr size_t WS_Z = 250 * MiB;
constexpr size_t WS_XG = WS_Z, WS_ACT = WS_Z + 96 * MiB;
constexpr size_t WS_XN = 378 * MiB;
constexpr size_t WS_YPRE = 410 * MiB, WS_YSSM = 426 * MiB;
constexpr size_t WS_Y = WS_XN;
constexpr size_t WS_YATT = 442 * MiB;
constexpr size_t WS_T1 = 458 * MiB, WS_MG = 490 * MiB;
constexpr size_t WS_END = 522 * MiB;
constexpr int CW_CNT = 64;
constexpr int CW_BAR = 4096;
constexpr int RING_OFF = 0, RING_BYTES = 131072;
constexpr int LDSCTL_OFF = RING_BYTES, MISC_OFF = LDSCTL_OFF + 320;
constexpr int LDS_BYTES = 147456;
#define GAS __attribute__((address_space(1)))
#define LAS __attribute__((address_space(3)))
typedef unsigned short bf16;
typedef unsigned v4u __attribute__((ext_vector_type(4)));
typedef float f32x4 __attribute__((ext_vector_type(4)));
typedef short bf16x8 __attribute__((ext_vector_type(8)));
typedef GAS unsigned gu32;
typedef GAS unsigned long long gu64;
#define RLX_AGENT __ATOMIC_RELAXED, __HIP_MEMORY_SCOPE_AGENT
#define LDS_WAIT() asm volatile("s_waitcnt lgkmcnt(0)" ::: "memory")
#define VM_WAIT() asm volatile("s_waitcnt vmcnt(0)" ::: "memory")
__device__ __forceinline__ unsigned long long rt() { return __builtin_amdgcn_s_memrealtime(); }
__device__ __forceinline__ unsigned f2bf(float f) { unsigned u = __builtin_bit_cast(unsigned, f); return (u + 0x7fffu + ((u >> 16) & 1u)) >> 16; }
__device__ __forceinline__ unsigned pk2(float lo, float hi) { return f2bf(lo) | (f2bf(hi) << 16); }

#define XB_TMO      128
#define XB_XCNT(j)  (256  + 64 * (j))
#define XB_XSUB(j)  (1280 + 64 * (j))
#define XB_XGEN(j)  (2304 + 64 * (j))
#define XB_TOP      3328
#define XB_TOPGEN   3392
#define XCD_BAR_WORDS 3456
#define XB_SPIN_CAP (1u << 18)

__device__ __forceinline__ unsigned xb_ld(unsigned* p)              { return __hip_atomic_load(p, __ATOMIC_RELAXED, __HIP_MEMORY_SCOPE_AGENT); }
__device__ __forceinline__ unsigned xb_add(unsigned* p, unsigned v) { return __hip_atomic_fetch_add(p, v, __ATOMIC_RELAXED, __HIP_MEMORY_SCOPE_AGENT); }
__device__ __forceinline__ unsigned xb_xcc_id() { return (unsigned)__builtin_amdgcn_s_getreg((3 << 11) | 20) & 0xFu; }
#define XB_SPIN(cond, bar) do { unsigned _sp = 0; while (cond) { __builtin_amdgcn_s_sleep(1); \
    if ((++_sp & 255u) == 0u) { if (xb_ld(&(bar)[XB_TMO])) break; if (_sp > XB_SPIN_CAP) { atomicAdd(&(bar)[XB_TMO], 1u); break; } } } } while (0)

struct XcdBarrier {
    unsigned* bar; unsigned x;
    volatile LAS unsigned* st;
};

__device__ __forceinline__ XcdBarrier xcd_barrier_post(unsigned* bar, volatile LAS unsigned* st) {
    XcdBarrier b; b.bar = bar; b.x = xb_xcc_id(); b.st = st;
    if (threadIdx.x == 0) (void)xb_add(&bar[XB_XCNT(b.x)], 1u);
    return b;
}
__device__ __forceinline__ void xcd_barrier_complete(unsigned* bar, unsigned x, unsigned& nloc, unsigned& nx) {
    const unsigned G = gridDim.x * gridDim.y * gridDim.z;
    unsigned sum, cnt, mine, sp = 0u;
    for (;;) {
        sum = 0u; cnt = 0u; mine = 0u;
#pragma unroll
        for (unsigned j = 0; j < 16; ++j) { const unsigned c = xb_ld(&bar[XB_XCNT(j)]); sum += c; cnt += (c > 0u) ? 1u : 0u; mine = (j == x) ? c : mine; }
        if (sum == G) break;
        __builtin_amdgcn_s_sleep(1);
        if ((++sp & 255u) == 0u) { if (xb_ld(&bar[XB_TMO])) break; if (sp > XB_SPIN_CAP) { atomicAdd(&bar[XB_TMO], 1u); break; } }
    }
    nloc = mine > 0u ? mine : 1u; nx = cnt > 0u ? cnt : 1u;
}

__device__ __forceinline__ void xcd_barrier(const XcdBarrier& b) {
    asm volatile("s_waitcnt vmcnt(0)" ::: "memory");
    __syncthreads();
    if (threadIdx.x == 0) {
        unsigned* bar = b.bar;
        __builtin_amdgcn_s_waitcnt(0);
        unsigned nloc = b.st[0], nx = b.st[1];
        if (nloc == 0u) { xcd_barrier_complete(bar, b.x, nloc, nx); b.st[0] = nloc; b.st[1] = nx; }
        const unsigned old = xb_add(&bar[XB_XSUB(b.x)], 1u);
        const unsigned gen = old / nloc;
        if (old + 1u == (gen + 1u) * nloc) {
            __builtin_amdgcn_fence(__ATOMIC_RELEASE, "agent");
            asm volatile("s_waitcnt vmcnt(0)" ::: "memory");
            const unsigned og = xb_add(&bar[XB_TOP], 1u);
            const unsigned tg = og / nx;
            if (og + 1u == (tg + 1u) * nx) xb_add(&bar[XB_TOPGEN], 1u);
            else XB_SPIN(xb_ld(&bar[XB_TOPGEN]) == tg, bar);
            __builtin_amdgcn_fence(__ATOMIC_ACQUIRE, "agent");
            xb_add(&bar[XB_XGEN(b.x)], 1u);
            asm volatile("s_waitcnt vmcnt(0)" ::: "memory");
        } else {
            XB_SPIN(xb_ld(&bar[XB_XGEN(b.x)]) == gen, bar);
            __builtin_amdgcn_fence(__ATOMIC_ACQUIRE, "agent");
            asm volatile("s_waitcnt vmcnt(0)" ::: "memory");
        }
    }
    __syncthreads();
}

struct Args {
    const float* in[29]; const int* pos; float* out; unsigned char* ws; int ph_lo, ph_hi;
};
struct Frame {
    LAS unsigned char* lds; volatile LAS unsigned* MISC; gu32* ctl;
    int tid, lane, wave, vcu, G;
};
__device__ __forceinline__ float wave_sum(float v) {
#pragma unroll
    for (int o = 1; o < 64; o <<= 1) v += __shfl_xor(v, o);
    return v;
}
__device__ __forceinline__ void sincos_acc(double ang, float& s, float& c) {
    const double k = __builtin_rint(ang * 0.63661977236758134308), y = __builtin_fma(-k, 1.57079632679489661923, ang) - k * 6.123233995736766e-17, y2 = y * y;
    const double sp = y * (1.0 + y2 * (-1.0 / 6 + y2 * (1.0 / 120 + y2 * (-1.0 / 5040 + y2 * (1.0 / 362880 + y2 * (-1.0 / 39916800))))));
    const double cp = 1.0 + y2 * (-0.5 + y2 * (1.0 / 24 + y2 * (-1.0 / 720 + y2 * (1.0 / 40320 + y2 * (-1.0 / 3628800 + y2 * (1.0 / 479001600))))));
    const int q = (int)((long long)k & 3);
    const double ss = (q == 0) ? sp : (q == 1) ? cp : (q == 2) ? -sp : -cp;
    const double cc = (q == 0) ? cp : (q == 1) ? -sp : (q == 2) ? -cp : sp;
    s = (float)ss; c = (float)cc;
}
template <int MODE>
__device__ __forceinline__ void p0_transpose_item(const float* W, int K, int N, bf16* WT, int row_off, LAS float* scr, int kb, int nb, int lane) {
    const int k0 = 64 * kb, n0 = 32 * nb;
#pragma unroll 8
    for (int i = 0; i < 32; ++i) { const int kk = 2 * i + (lane >> 5); scr[kk * 33 + (lane & 31)] = W[(size_t)(k0 + kk) * N + n0 + (lane & 31)]; }
    LDS_WAIT(); asm volatile("" ::: "memory");
    const int c = lane & 7;
#pragma unroll
    for (int j = 0; j < 4; ++j) { const int n = (lane >> 3) + 8 * j; const LAS float* s = scr + (8 * c) * 33 + n;
        v4u o; o.x = pk2(s[0 * 33], s[1 * 33]); o.y = pk2(s[2 * 33], s[3 * 33]); o.z = pk2(s[4 * 33], s[5 * 33]); o.w = pk2(s[6 * 33], s[7 * 33]);
        int row = row_off + n0 + n;
        if (MODE == 1) { const int nn = n0 + n; if (nn >= ZQ && nn < ZV) { const int d = nn & 63, dd = d & 31; row = (nn & ~63) + 8 * (dd >> 2) + (dd & 3) + ((d >= 32) ? 4 : 0); } }
        *(GAS v4u*)(WT + (size_t)row * K + k0 + 8 * c) = o; }
    LDS_WAIT(); asm volatile("" ::: "memory");
}

__global__ void __launch_bounds__(NWAVES * 64, 2) mega_fwd(Args args) {
    extern __shared__ __attribute__((aligned(16))) unsigned char lds[];
    Frame F;
    F.lds = (LAS unsigned char*)lds;
    F.MISC = (volatile LAS unsigned*)(F.lds + MISC_OFF);
    F.tid = threadIdx.x; F.lane = F.tid & 63; F.wave = __builtin_amdgcn_readfirstlane(F.tid >> 6);
    F.G = gridDim.x; { const int bx = blockIdx.x; F.vcu = (F.G % 8 == 0) ? (bx % 8) * (F.G / 8) + bx / 8 : bx; }
    unsigned char* ws = args.ws;
    F.ctl = (gu32*)(ws + WS_CTL);
    for (int u = F.tid; u < (LDS_BYTES - LDSCTL_OFF) / 4; u += NWAVES * 64) ((LAS unsigned*)(F.lds + LDSCTL_OFF))[u] = 0u;
    __syncthreads();
    const int lo = args.ph_lo, hi = args.ph_hi; const bool multi = (hi - lo) > 1;
    XcdBarrier bar; bar.bar = (unsigned*)(F.ctl + CW_BAR); bar.x = 0; bar.st = nullptr;
    if (multi) bar = xcd_barrier_post((unsigned*)(F.ctl + CW_BAR), F.MISC + 8);
#ifndef PHASE_MASK
#define PHASE_MASK 0xfff
#endif
#define IN(k) (((PHASE_MASK >> (k)) & 1) && lo <= (k) && (k) < hi)
#define GRID_BAR() do { if (multi) xcd_barrier(bar); } while (0)
    const int gw = F.vcu * NWAVES + F.wave, NGW = F.G * NWAVES;
    float* ROPE = (float*)(ws + WS_ROPE);
    ssm::f32x2* ABAR = (ssm::f32x2*)(ws + WS_SSMT); bf16* BBART = (bf16*)(ws + WS_SSMT + 32768); bf16* CMATT = (bf16*)(ws + WS_SSMT + 32768 + 262144);
    ssm::f32x2* ESTATE = (ssm::f32x2*)(ws + WS_SSMT + 1 * MiB);
    int* R_EID = (int*)(ws + WS_ROUTE); int* R_POS = R_EID + 2 * S_; float* R_GATE = (float*)(R_POS + 2 * S_);
    int* SLOT_OF = (int*)(R_GATE + 2 * S_); float* SLOT_W = (float*)(SLOT_OF + XG_ROWS); int* WGCNT = (int*)(SLOT_W + XG_ROWS);
    bf16* WIN = (bf16*)(ws + WS_WIN); bf16* WGLU = (bf16*)(ws + WS_WGLU); bf16* WPS = (bf16*)(ws + WS_WPS); bf16* WPA = (bf16*)(ws + WS_WPA); bf16* WOUT = (bf16*)(ws + WS_WOUT);
    bf16* WGU = (bf16*)(ws + WS_WGU); bf16* WD = (bf16*)(ws + WS_WD);
    bf16* Z = (bf16*)(ws + WS_Z); bf16* XG = (bf16*)(ws + WS_XG); bf16* ACT = (bf16*)(ws + WS_ACT);
    bf16* XN = (bf16*)(ws + WS_XN); bf16* H2 = XN; bf16* YB = (bf16*)(ws + WS_Y);
    bf16* YPRE = (bf16*)(ws + WS_YPRE); bf16* YSSM = (bf16*)(ws + WS_YSSM); bf16* YATT = (bf16*)(ws + WS_YATT);
    bf16* T1 = (bf16*)(ws + WS_T1); bf16* MG = (bf16*)(ws + WS_MG);
    const float* x = args.in[0];

    if (IN(0)) {
        LAS float* scr = (LAS float*)(F.lds + RING_OFF + F.wave * 16384);
        constexpr int I0 = 8192, I1 = I0 + 512, I2 = I1 + 1024, I3 = I2 + 1024, I4 = I3 + 2048, I5 = I4 + 16384, I6 = I5 + 16384, I7 = I6 + 16384;
        for (int it = gw; it < I7; it += NGW) {
            if (it < I0) { p0_transpose_item<1>(args.in[3], DM, INW, WIN, 0, scr, it / 256, it % 256, F.lane); }
            else if (it < I1) { const int r = it - I0; p0_transpose_item<0>(args.in[12], 1024, 1024, WGLU, 0, scr, r / 32, r % 32, F.lane); }
            else if (it < I2) { const int r = it - I1; p0_transpose_item<0>(args.in[19], 1024, DM, WPS, 0, scr, r / 64, r % 64, F.lane); }
            else if (it < I3) { const int r = it - I2; p0_transpose_item<0>(args.in[20], 1024, DM, WPA, 0, scr, r / 64, r % 64, F.lane); }
            else if (it < I4) { const int r = it - I3; p0_transpose_item<0>(args.in[21], DM, DM, WOUT, 0, scr, r / 64, r % 64, F.lane); }
            else if (it < I6) { const int up = it >= I5, r = it - (up ? I5 : I4), e = r >> 9, q = r & 511, kb = q >> 4, nb = q & 15;
                const int n0 = 32 * nb, roff = 256 * (n0 >> 7) + 128 * up + (n0 & 127) - n0;
                p0_transpose_item<0>(args.in[up ? 26 : 25] + (size_t)e * DM * DFF, DM, DFF, WGU + (size_t)e * 1024 * DM, roff, scr, kb, nb, F.lane); }
            else { const int r = it - I6, e = r >> 9, q = r & 511, kb = q >> 6, nb = q & 63;
                p0_transpose_item<0>(args.in[27] + (size_t)e * DFF * DM, DFF, DM, WD + (size_t)e * DM * DFF, 0, scr, kb, nb, F.lane); }
        }
        { const float* w1 = args.in[2];
          for (int m = gw; m < S_; m += NGW) {
            const GAS f32x4* xr = (const GAS f32x4*)(x + (size_t)m * DM) + F.lane; f32x4 v[8]; float s = 0.f;
#pragma unroll
            for (int j = 0; j < 8; ++j) { v[j] = xr[64 * j]; s += (v[j].x * v[j].x + v[j].y * v[j].y) + (v[j].z * v[j].z + v[j].w * v[j].w); }
            const float rstd = __builtin_amdgcn_rsqf(wave_sum(s) * (1.f / DM) + 1e-6f);
            GAS unsigned long long* o8 = (GAS unsigned long long*)(XN + (size_t)m * DM) + F.lane;
#pragma unroll
            for (int j = 0; j < 8; ++j) { const f32x4 w = *((const f32x4*)w1 + F.lane + 64 * j);
                o8[64 * j] = (unsigned long long)pk2(v[j].x * rstd * w.x, v[j].y * rstd * w.y) | ((unsigned long long)pk2(v[j].z * rstd * w.z, v[j].w * rstd * w.w) << 32); }
          } }
        { const int gt = F.vcu * (NWAVES * 64) + F.tid, NGT = F.G * NWAVES * 64;
          for (int e = gt; e < S_ * 32; e += NGT) { const int row = e >> 5, i = e & 31;
            const float inv_freq = 1.0f / __builtin_powf(10000.0f, (float)(2 * i) * (1.0f / 64.0f));
            const float ang = (float)args.pos[row] * inv_freq; float s, c; sincos_acc((double)ang, s, c);
            ROPE[(size_t)row * 64 + i] = c; ROPE[(size_t)row * 64 + 32 + i] = s; }
          for (int e = gt; e < 64 * 64; e += NGT) { const int g = e >> 6, p = e & 63;
            const float lr = args.in[4][e], li = args.in[5][e]; const float dt = __builtin_expf(args.in[6][g]);
            const float mag = __builtin_expf(lr * dt); float sn, cs; sincos_acc((double)(li * dt), sn, cs);
            const float ar = mag * cs, ai = mag * sn, nr = ar - 1.f, ni = ai, den = lr * lr + li * li;
            const float fr = (nr * lr + ni * li) / den, fi = (ni * lr - nr * li) / den;
            ABAR[e] = (ssm::f32x2){ar, ai};
            const float* br = args.in[7] + (size_t)e * 16; const float* bi = args.in[8] + (size_t)e * 16;
#pragma unroll
            for (int m = 0; m < 16; m += 2) {
                const float r0 = fr * br[m] - fi * bi[m], i0 = fr * bi[m] + fi * br[m], r1 = fr * br[m + 1] - fi * bi[m + 1], i1 = fr * bi[m + 1] + fi * br[m + 1];
                *(unsigned*)(BBART + ((size_t)((g * 2 + 0) * 64 + p) * 16 + m)) = pk2(r0, r1);
                *(unsigned*)(BBART + ((size_t)((g * 2 + 1) * 64 + p) * 16 + m)) = pk2(i0, i1); }
#pragma unroll
            for (int m = 0; m < 16; ++m) *(unsigned*)(CMATT + ((size_t)(g * 16 + m) * 128 + 2 * p)) = pk2(args.in[9][(size_t)(g * 16 + m) * 64 + p], -args.in[10][(size_t)(g * 16 + m) * 64 + p]);
          } }
        GRID_BAR();
    }
    if (IN(1)) {
        pg8::Gemm g{XN, WIN, S_, INW, DM}; pg8::StaticOrder S; S.init(S_, INW, F.G, (int)blockIdx.x);
        pg8::EpiInProj E{Z, ROPE};
        pg8::gemm_phase<pg8::EpiInProj, pg8::StaticOrder, true, true>(F.lds + RING_OFF, g, S, E);
        GRID_BAR();
    }
    if (IN(2)) {
        for (int it = gw; it < 64 * ssm::NRUN; it += NGW)
            ssm::run_item<false>(it >> 5, it & 31, F.lane, Z, ABAR, BBART, CMATT, args.in[11], ESTATE, YPRE, (LAS char*)(F.lds + F.wave * ssm::WAVE_LDS));
        GRID_BAR();
    }
    if (IN(3)) {
        for (int it = gw; it < 64 * ssm::NRUN; it += NGW)
            ssm::run_item<true>(it >> 5, it & 31, F.lane, Z, ABAR, BBART, CMATT, args.in[11], ESTATE, YPRE, (LAS char*)(F.lds + F.wave * ssm::WAVE_LDS));
        __syncthreads();
        const float s1 = wave_sum(args.in[14][F.lane] * args.in[15][F.lane]), s2 = wave_sum(args.in[16][F.lane] * args.in[17][F.lane]);
        const float lam = __builtin_expf(s1) - __builtin_expf(s2) + 0.2f;
        for (int u = F.vcu; u < 256; u += F.G) { const int h = u >> 5, s = u & 31;
            att::attn_block(h, s, Z, ZQ, ZK, ZV, lam, args.in[18], YATT, (LAS char*)F.lds);
            att::attn_block(h, 63 - s, Z, ZQ, ZK, ZV, lam, args.in[18], YATT, (LAS char*)F.lds); }
        GRID_BAR();
    }
    if (IN(4)) {
        pg8::Gemm g{YPRE, WGLU, S_, 1024, 1024}; pg8::StaticOrder S; S.init(S_, 1024, F.G, (int)blockIdx.x);
        pg8::EpiGlu E{YPRE, args.in[13], YSSM};
        pg8::gemm_phase<pg8::EpiGlu, pg8::StaticOrder, true, true>(F.lds + RING_OFF, g, S, E);
        GRID_BAR();
    }
    if (IN(5)) {
        { pg8::Gemm g{YSSM, WPS, S_, DM, 1024}; pg8::StaticOrder S; S.init(S_, DM, F.G, (int)blockIdx.x);
          pg8::EpiProj<true> E{Z, ZGS, T1, MG};
          pg8::gemm_phase<pg8::EpiProj<true>, pg8::StaticOrder, true, true>(F.lds + RING_OFF, g, S, E); }
        VM_WAIT(); __syncthreads();
        { pg8::Gemm g{YATT, WPA, S_, DM, 1024}; pg8::StaticOrder S; S.init(S_, DM, F.G, (int)blockIdx.x);
          pg8::EpiProj<false> E{Z, ZGA, T1, MG};
          pg8::gemm_phase<pg8::EpiProj<false>, pg8::StaticOrder, true, true>(F.lds + RING_OFF, g, S, E); }
        GRID_BAR();
    }
    if (IN(6)) {
        pg8::Gemm g{MG, WOUT, S_, DM, DM}; pg8::StaticOrder S; S.init(S_, DM, F.G, (int)blockIdx.x);
        pg8::EpiOut E{x, args.out};
        pg8::gemm_phase<pg8::EpiOut, pg8::StaticOrder, true, true>(F.lds + RING_OFF, g, S, E);
        GRID_BAR();
    }
    if (IN(7)) {
        const float* w2 = args.in[22]; const float* rg = args.in[23]; const float* re = args.in[24];
        int ln = F.lane; asm volatile("" : "+v"(ln));
        LAS float* PL = (LAS float*)F.lds;
        LAS float* PS = PL + 8 * 32 * 36;
        LAS float* TL = PS + 8 * 32;
        LAS float* RS = TL + 32 * 36; LAS int* EL = (LAS int*)(RS + 32);
        for (int rb = F.vcu; rb < S_ / 32; rb += F.G) {
            const int R0 = 32 * rb, i = ln & 31, kk = ln >> 5;
            const float* xa = args.out + (size_t)(R0 + i) * DM + 256 * F.wave + kk;
            const int kb = 256 * F.wave + kk;
            att::f32x16 accE = {}, accG = {}; float ssq = 0.f;
#pragma unroll 8
            for (int s = 0; s < 128; ++s) { const int k = kb + 2 * s;
                const float a = xa[2 * s], wk = w2[k];
                const float bE = re[k * 32 + i] * wk, bG = (i < 4) ? rg[k * 4 + i] * wk : 0.f;
                ssq = fmaf(a, a, ssq);
                accE = __builtin_amdgcn_mfma_f32_32x32x2f32(a, bE, accE, 0, 0, 0);
                accG = __builtin_amdgcn_mfma_f32_32x32x2f32(a, bG, accG, 0, 0, 0); }
#pragma unroll
            for (int r = 0; r < 16; ++r) { const int row = (r & 3) + 8 * (r >> 2) + 4 * kk;
                PL[(F.wave * 32 + row) * 36 + 4 + i] = accE[r]; if (i < 4) PL[(F.wave * 32 + row) * 36 + i] = accG[r]; }
            ssq += __shfl_xor(ssq, 32);
            if (kk == 0) PS[F.wave * 32 + i] = ssq;
            __syncthreads();
            { const int row = F.tid >> 4, jq = F.tid & 15;
#pragma unroll
              for (int c = jq; c < 36; c += 16) { float t = 0.f;
#pragma unroll
                  for (int w = 0; w < 8; ++w) t += PL[(w * 32 + row) * 36 + c];
                  TL[row * 36 + c] = t; }
              if (F.tid < 32) { float t = 0.f;
#pragma unroll
                  for (int w = 0; w < 8; ++w) t += PS[w * 32 + F.tid];
                  RS[F.tid] = __builtin_amdgcn_rsqf(t * (1.f / DM) + 1e-6f); } }
            __syncthreads();
            if (F.tid < 32) { const int m = R0 + F.tid; const float rs = RS[F.tid]; const LAS float* tl = TL + F.tid * 36;
                float gl[4];
#pragma unroll
                for (int g = 0; g < 4; ++g) gl[g] = tl[g] * rs;
                int gi = 0; float gm = gl[0];
#pragma unroll
                for (int g = 1; g < 4; ++g) if (gl[g] > gm) { gm = gl[g]; gi = g; }
                float gs = 0.f;
#pragma unroll
                for (int g = 0; g < 4; ++g) gs += __builtin_expf(gl[g] - gm);
                const float gval = 1.f / gs;
                float el[8];
#pragma unroll
                for (int e = 0; e < 8; ++e) el[e] = tl[4 + gi * 8 + e] * rs;
                int i0 = 0; float v0 = el[0];
#pragma unroll
                for (int e = 1; e < 8; ++e) if (el[e] > v0) { v0 = el[e]; i0 = e; }
                int i1 = 0; float v1 = -__builtin_inff();
#pragma unroll
                for (int e = 0; e < 8; ++e) if (e != i0 && el[e] > v1) { v1 = el[e]; i1 = e; }
                const float e1 = __builtin_expf(v1 - v0), den = 1.f + e1;
                const int ea = gi * 8 + i0, eb = gi * 8 + i1;
                R_EID[2 * m] = ea; R_EID[2 * m + 1] = eb; R_GATE[2 * m] = gval / den; R_GATE[2 * m + 1] = gval * e1 / den;
                EL[2 * F.tid] = ea; EL[2 * F.tid + 1] = eb; }
            __syncthreads();
            if (F.tid < 64) { const int me = EL[F.tid]; int rk = 0;
                for (int q = 0; q < 64; ++q) rk += (q < F.tid && EL[q] == me) ? 1 : 0;
                R_POS[2 * R0 + F.tid] = rk; }
            else if (F.tid < 96) { const int e = F.tid - 64; int c = 0;
                for (int q = 0; q < 64; ++q) c += (EL[q] == e) ? 1 : 0;
                WGCNT[rb * 32 + e] = c; }
#pragma unroll
            for (int q = 0; q < 4; ++q) { const int row = 4 * F.wave + q; const float rs = RS[row];
                const GAS f32x4* xr = (const GAS f32x4*)(args.out + (size_t)(R0 + row) * DM) + ln; GAS unsigned long long* o8 = (GAS unsigned long long*)(H2 + (size_t)(R0 + row) * DM) + ln;
#pragma unroll
                for (int j = 0; j < 8; ++j) { const f32x4 v = xr[64 * j] * rs * *((const f32x4*)w2 + ln + 64 * j);
                    o8[64 * j] = (unsigned long long)pk2(v.x, v.y) | ((unsigned long long)pk2(v.z, v.w) << 32); } }
            __syncthreads();
        }
        GRID_BAR();
    }
    LAS int* RT = (LAS int*)(F.lds + LDSCTL_OFF); LAS int* CNTL = RT + 36; LAS int* PSUM = (LAS int*)(F.lds + RING_OFF + 65536);
    if (hi > 8 && lo <= 10) {
        { const int e = F.tid & 31, part = F.tid >> 5; int c = 0;
#pragma unroll
          for (int q = 0; q < 16; ++q) c += WGCNT[(16 * part + q) * 32 + e];
          PSUM[part * 32 + e] = c; }
        __syncthreads();
        if (F.tid < 32) { int c = 0;
#pragma unroll
            for (int p = 0; p < 16; ++p) c += PSUM[p * 32 + F.tid];
            CNTL[F.tid] = c; }
        __syncthreads();
        if (F.tid == 0) { int acc = 0; for (int e = 0; e < 32; ++e) { RT[e] = acc; acc += (CNTL[e] + 255) >> 8; } RT[32] = acc; }
        __syncthreads();
    }
    if (IN(8)) {
        LAS int* BASE = PSUM + 16 * 32;
        for (int rb = F.vcu; rb < S_ / 32; rb += F.G) {
            if (F.tid < 32) { int c = 0; const int p0 = rb >> 4;
                for (int p = 0; p < p0; ++p) c += PSUM[p * 32 + F.tid];
                for (int q = 16 * p0; q < rb; ++q) c += WGCNT[q * 32 + F.tid];
                BASE[F.tid] = c; }
            __syncthreads();
#pragma unroll
            for (int q = 0; q < 4; ++q) { const int m = 32 * rb + 4 * F.wave + q;
#pragma unroll
                for (int k = 0; k < 2; ++k) { const int e = R_EID[2 * m + k], dst = RT[e] * 256 + BASE[e] + R_POS[2 * m + k];
                    const GAS v4u* src = (const GAS v4u*)(H2 + (size_t)m * DM) + F.lane; GAS v4u* dp = (GAS v4u*)(XG + (size_t)dst * DM) + F.lane;
#pragma unroll
                    for (int j = 0; j < 4; ++j) dp[64 * j] = src[64 * j];
                    if (F.lane == 0) { SLOT_OF[dst] = 2 * m + k; SLOT_W[dst] = R_GATE[2 * m + k]; } } }
            __syncthreads();
        }
        for (int e = gw; e < 32; e += NGW) { const int cnt = CNTL[e], b = RT[e] * 256 + cnt, en = RT[e + 1] * 256;
            for (int r = b + F.lane; r < en; r += 64) { SLOT_OF[r] = -1; SLOT_W[r] = 0.f; } }
        GRID_BAR();
    }
    if (IN(9)) {
        pg8::Gemm g{XG, WGU, 0, 0, DM}; pg8::MoeOrder S{RT, 4, F.G, F.vcu};
        pg8::EpiMoeUp E{ACT};
        pg8::gemm_phase<pg8::EpiMoeUp, pg8::MoeOrder, true, true>(F.lds + RING_OFF, g, S, E);
        GRID_BAR();
    }
    if (IN(10)) {
        pg8::Gemm g{ACT, WD, 0, 0, DFF}; pg8::MoeOrder S{RT, 8, F.G, F.vcu};
        pg8::EpiMoeDown E{SLOT_OF, SLOT_W, YB};
        pg8::gemm_phase<pg8::EpiMoeDown, pg8::MoeOrder, true, true>(F.lds + RING_OFF, g, S, E);
        GRID_BAR();
    }
    if (IN(11)) {
        const float* fw = args.in[28];
        int ln = F.lane; asm volatile("" : "+v"(ln));
        for (int m = gw; m < S_; m += NGW) {
            GAS f32x4* xr = (GAS f32x4*)(args.out + (size_t)m * DM) + ln; f32x4 v[8]; float s = 0.f;
            const GAS unsigned long long* ya = (const GAS unsigned long long*)(YB + (size_t)(2 * m) * DM) + ln; const GAS unsigned long long* yb = ya + DM / 4;
#pragma unroll
            for (int j = 0; j < 8; ++j) { v[j] = xr[64 * j]; const unsigned long long a = ya[64 * j], b = yb[64 * j];
                const unsigned a0 = (unsigned)a, a1 = (unsigned)(a >> 32), b0 = (unsigned)b, b1 = (unsigned)(b >> 32);
                v[j].x += pg8::bf_lo(a0) + pg8::bf_lo(b0); v[j].y += pg8::bf_hi(a0) + pg8::bf_hi(b0); v[j].z += pg8::bf_lo(a1) + pg8::bf_lo(b1); v[j].w += pg8::bf_hi(a1) + pg8::bf_hi(b1);
                s += (v[j].x * v[j].x + v[j].y * v[j].y) + (v[j].z * v[j].z + v[j].w * v[j].w); }
            const float rstd = __builtin_amdgcn_rsqf(wave_sum(s) * (1.f / DM) + 1e-6f);
#pragma unroll
            for (int j = 0; j < 8; ++j) { const f32x4 w = *((const f32x4*)fw + ln + 64 * j); xr[64 * j] = v[j] * rstd * w; }
        }
    }
#undef IN
#undef GRID_BAR
}

extern "C" void kernel_launch(void* const* d_in, const int* in_sizes, int n_in, void* d_out, int out_size, void* d_ws, size_t ws_size, hipStream_t stream) {
    static int grid = 0;
    if (grid == 0) {
        if (n_in != 29 || out_size != S_ * DM || ws_size < WS_END) { fprintf(stderr, "kernel_launch: unexpected shapes (n_in %d out %d ws %zu)\n", n_in, out_size, ws_size); grid = -1; return; }
        int dev = 0, cus = 0;
        if (hipGetDevice(&dev) != hipSuccess || hipDeviceGetAttribute(&cus, hipDeviceAttributeMultiprocessorCount, dev) != hipSuccess) { grid = -1; return; }
        if (hipFuncSetAttribute((const void*)mega_fwd, hipFuncAttributeMaxDynamicSharedMemorySize, LDS_BYTES) != hipSuccess) { fprintf(stderr, "kernel_launch: hipFuncSetAttribute failed\n"); grid = -1; return; }
        grid = cus;
    }
    if (grid < 0) return;
    (void)in_sizes;
    if (hipMemsetAsync((char*)d_ws + WS_CTL, 0, CTL_ZERO_BYTES, stream) != hipSuccess) return;
    Args a{};
    for (int i = 0; i < 29; ++i) a.in[i] = (const float*)d_in[i];
    a.pos = (const int*)d_in[1]; a.out = (float*)d_out; a.ws = (unsigned char*)d_ws;
#ifndef MK_SPLIT
    a.ph_lo = 0; a.ph_hi = 12;
    hipLaunchKernelGGL(mega_fwd, dim3(grid), dim3(NWAVES * 64), LDS_BYTES, stream, a);
#else
    for (int p = 0; p < 12; ++p) { a.ph_lo = p; a.ph_hi = p + 1; hipLaunchKernelGGL(mega_fwd, dim3(grid), dim3(NWAVES * 64), LDS_BYTES, stream, a); }
#endif
}
```
